# Optimizing an MI355X kernel written in HIP

```python
import math
import jax, jax.numpy as jnp
from jax import lax
import numpy as np

D_MODEL = 1024
BATCH = 2
SEQ = 16384
DEPTH = 4

CHUNK = 64
N_MIXERS = 3
DEEPNORM_ALPHA = (2 * DEPTH) ** 0.25
DEEPNORM_BETA = (8 * DEPTH) ** -0.25
LN_EPS = 1e-5
RMS_EPS = 1e-6
NEG_INF = -1e30

GLA_HEADS = 4
GLA_DK = D_MODEL // 2 // GLA_HEADS
GLA_DV = D_MODEL // GLA_HEADS
GLA_GATE_RANK = 16
GLA_TAU = 16.0
GLA_HK = GLA_HEADS * GLA_DK
GLA_HV = GLA_HEADS * GLA_DV

RPA_HEADS = 16
RPA_HEAD_DIM = D_MODEL // RPA_HEADS
RPA_LEFT_CHUNKS = 8
RPA_BAND = (RPA_LEFT_CHUNKS + 1) * CHUNK
RPA_MAX_REL = 128

MLA_HEADS = 8
MLA_NOPE = 128
MLA_ROPE = 64
MLA_V = 128
MLA_Q_RANK = 384
MLA_KV_RANK = 256
MLA_QK = MLA_NOPE + MLA_ROPE
ROPE_BASE = 10000.0
Q_BLOCK = 128

FFN_HIDDEN = -(-8 * D_MODEL // (3 * 256)) * 256

N_GLA = len(range(0, DEPTH, N_MIXERS))
N_RPA = len(range(1, DEPTH, N_MIXERS))
N_MLA = len(range(2, DEPTH, N_MIXERS))

kernel_name = "hybrid_gla_chunkrel_mla_deepnorm"


def layer_norm(x, g, b):
    xf = x.astype(jnp.float32)
    mu = jnp.mean(xf, -1, keepdims=True)
    var = jnp.mean(jnp.square(xf - mu), -1, keepdims=True)
    y = (xf - mu) * lax.rsqrt(var + LN_EPS)
    return (y * g.astype(jnp.float32) + b.astype(jnp.float32)).astype(x.dtype)


def rms_norm(x, g):
    xf = x.astype(jnp.float32)
    y = xf * lax.rsqrt(jnp.mean(jnp.square(xf), -1, keepdims=True) + RMS_EPS)
    return (y * g.astype(jnp.float32)).astype(x.dtype)


def gla_mixer(x, w_in, w_gate_up, b_gate, norm_g, w_out):
    B, S, _ = x.shape
    nc = S // CHUNK
    f32 = jnp.float32
    q, k, v, r, g_low = jnp.split(
        x @ w_in, [GLA_HK, 2 * GLA_HK, 2 * GLA_HK + GLA_HV, 2 * GLA_HK + 2 * GLA_HV], axis=-1)
    log_a = jax.nn.log_sigmoid((g_low @ w_gate_up + b_gate).astype(f32)) / GLA_TAU

    def to_chunks(t, d):
        return t.astype(f32).reshape(B, nc, CHUNK, GLA_HEADS, d).transpose(0, 3, 1, 2, 4)

    q = to_chunks(q, GLA_DK) * (GLA_DK ** -0.5)
    k = to_chunks(k, GLA_DK)
    v = to_chunks(v, GLA_DV)
    cum = jnp.cumsum(to_chunks(log_a, GLA_DK), axis=3)
    total = cum[:, :, :, -1:, :]
    q_dec = q * jnp.exp(cum)
    k_inv = k * jnp.exp(-cum)
    k_end = k * jnp.exp(total - cum)
    causal = jnp.tril(jnp.ones((CHUNK, CHUNK), dtype=bool))
    a = jnp.where(causal, jnp.einsum('bhcid,bhcjd->bhcij', q_dec, k_inv), 0.0)
    o_intra = jnp.einsum('bhcij,bhcjv->bhciv', a, v)
    decay = jnp.swapaxes(jnp.exp(total), -1, -2)

    def step(state, inp):
        qd, ke, vc, dc = inp
        o = jnp.einsum('bhid,bhdv->bhiv', qd, state)
        state = state * dc + jnp.einsum('bhjd,bhjv->bhdv', ke, vc)
        return state, o

    state0 = jnp.zeros((B, GLA_HEADS, GLA_DK, GLA_DV), f32)
    xs = (jnp.moveaxis(q_dec, 2, 0), jnp.moveaxis(k_end, 2, 0),
          jnp.moveaxis(v, 2, 0), jnp.moveaxis(decay, 2, 0))
    _, o_inter = lax.scan(step, state0, xs)
    o = o_intra + jnp.moveaxis(o_inter, 0, 2)
    o = o.transpose(0, 2, 3, 1, 4).reshape(B, S, GLA_HEADS, GLA_DV)
    mu = jnp.mean(o, -1, keepdims=True)
    var = jnp.mean(jnp.square(o - mu), -1, keepdims=True)
    o = ((o - mu) * lax.rsqrt(var + LN_EPS)).reshape(B, S, GLA_HV) * norm_g.astype(f32)
    y = jax.nn.silu(r.astype(f32)) * o
    return y.astype(x.dtype) @ w_out


def rpa_mixer(x, w_in, rel_bias, w_out):
    B, S, _ = x.shape
    nc = S // CHUNK
    pad = RPA_LEFT_CHUNKS * CHUNK
    q, k, v = jnp.split(x @ w_in, 3, axis=-1)
    q = q.reshape(B, nc, CHUNK, RPA_HEADS, RPA_HEAD_DIM) * (RPA_HEAD_DIM ** -0.5)
    padw = ((0, 0), (pad, 0), (0, 0), (0, 0))
    k = jnp.pad(k.reshape(B, S, RPA_HEADS, RPA_HEAD_DIM), padw)
    v = jnp.pad(v.reshape(B, S, RPA_HEADS, RPA_HEAD_DIM), padw)
    band_pos = jnp.arange(RPA_BAND)
    rel = jnp.clip(pad + jnp.arange(CHUNK)[:, None] - band_pos[None, :],
                   -RPA_MAX_REL, RPA_MAX_REL) + RPA_MAX_REL
    bias = rel_bias[:, rel].astype(jnp.float32)

    def one_chunk(c):
        q_c = lax.dynamic_index_in_dim(q, c, axis=1, keepdims=False)
        k_c = lax.dynamic_slice_in_dim(k, c * CHUNK, RPA_BAND, axis=1)
        v_c = lax.dynamic_slice_in_dim(v, c * CHUNK, RPA_BAND, axis=1)
        s = jnp.einsum('bihd,bjhd->bhij', q_c, k_c).astype(jnp.float32) + bias
        valid = (c * CHUNK - pad + band_pos) >= 0
        p = jax.nn.softmax(jnp.where(valid, s, NEG_INF), axis=-1)
        return jnp.einsum('bhij,bjhd->bihd', p.astype(v_c.dtype), v_c)

    o = lax.map(one_chunk, jnp.arange(nc))
    o = o.transpose(1, 0, 2, 3, 4).reshape(B, S, RPA_HEADS * RPA_HEAD_DIM)
    return o @ w_out


def rope_tables(S):
    inv = ROPE_BASE ** (-jnp.arange(0, MLA_ROPE, 2, dtype=jnp.float32) / MLA_ROPE)
    ang = jnp.arange(S, dtype=jnp.float32)[:, None] * inv[None, :]
    return jnp.cos(ang), jnp.sin(ang)


def apply_rope(t, cos, sin):
    extra = t.ndim - 3
    c = cos.reshape(cos.shape[0], *([1] * extra), cos.shape[1])
    s = sin.reshape(sin.shape[0], *([1] * extra), sin.shape[1])
    t1, t2 = jnp.split(t.astype(jnp.float32), 2, axis=-1)
    return jnp.concatenate([t1 * c - t2 * s, t1 * s + t2 * c], -1).astype(t.dtype)


def mla_mixer(x, w_in, q_norm_g, kv_norm_g, w_uq, w_ukv, w_out):
    B, S, _ = x.shape
    c_q, c_kv, k_rope = jnp.split(x @ w_in, [MLA_Q_RANK, MLA_Q_RANK + MLA_KV_RANK], axis=-1)
    q = (rms_norm(c_q, q_norm_g) @ w_uq).reshape(B, S, MLA_HEADS, MLA_QK)
    kv = (rms_norm(c_kv, kv_norm_g) @ w_ukv).reshape(B, S, MLA_HEADS, MLA_NOPE + MLA_V)
    q_nope, q_rope = jnp.split(q, [MLA_NOPE], axis=-1)
    k_nope, v = jnp.split(kv, [MLA_NOPE], axis=-1)
    cos, sin = rope_tables(S)
    q_rope = apply_rope(q_rope, cos, sin)
    k_rope = apply_rope(k_rope, cos, sin)
    scale = MLA_QK ** -0.5
    nqb = S // Q_BLOCK
    qn_b = jnp.moveaxis((q_nope * scale).reshape(B, nqb, Q_BLOCK, MLA_HEADS, MLA_NOPE), 1, 0)
    qr_b = jnp.moveaxis((q_rope * scale).reshape(B, nqb, Q_BLOCK, MLA_HEADS, MLA_ROPE), 1, 0)
    k_chunk = jnp.arange(S) // CHUNK

    def one_block(args):
        qn, qr, i = args
        s = (jnp.einsum('bqhd,bkhd->bhqk', qn, k_nope)
             + jnp.einsum('bqhr,bkr->bhqk', qr, k_rope)).astype(jnp.float32)
        q_chunk = (i * Q_BLOCK + jnp.arange(Q_BLOCK)) // CHUNK
        mask = k_chunk[None, :] <= q_chunk[:, None]
        p = jax.nn.softmax(jnp.where(mask, s, NEG_INF), axis=-1)
        return jnp.einsum('bhqk,bkhd->bqhd', p.astype(v.dtype), v)

    o = lax.map(one_block, (qn_b, qr_b, jnp.arange(nqb)))
    o = jnp.moveaxis(o, 0, 1).reshape(B, S, MLA_HEADS * MLA_V)
    return o @ w_out


def swiglu(x, w_in, w_out):
    gate, up = jnp.split(x @ w_in, 2, axis=-1)
    return (jax.nn.silu(gate) * up) @ w_out


def _w(k, shape, fan_in, scale=1.0):
    return jax.random.normal(k, shape, jnp.float32) * (scale * fan_in ** -0.5)


def setup_inputs(seed: int = 0) -> dict:
    key = jax.random.key(seed)
    ks = jax.random.split(key, 20)
    D = D_MODEL
    gla_cols = 2 * GLA_HK + 2 * GLA_HV + GLA_GATE_RANK
    mla_cols = MLA_Q_RANK + MLA_KV_RANK + MLA_ROPE
    return {
        "x": jax.random.normal(ks[0], (BATCH, SEQ, D), jnp.float32),
        "gla_w_in": _w(ks[1], (N_GLA, D, gla_cols), D),
        "gla_w_gate_up": _w(ks[2], (N_GLA, GLA_GATE_RANK, GLA_HK), GLA_GATE_RANK),
        "gla_b_gate": 0.1 * jax.random.normal(ks[3], (N_GLA, GLA_HK), jnp.float32),
        "gla_norm_g": 1.0 + 0.02 * jax.random.normal(ks[4], (N_GLA, GLA_HV), jnp.float32),
        "gla_w_out": _w(ks[5], (N_GLA, GLA_HV, D), GLA_HV, DEEPNORM_BETA),
        "rpa_w_in": _w(ks[6], (N_RPA, D, 3 * D), D),
        "rpa_rel_bias": 0.5 * jax.random.normal(ks[7], (N_RPA, RPA_HEADS, 2 * RPA_MAX_REL + 1), jnp.float32),
        "rpa_w_out": _w(ks[8], (N_RPA, D, D), D, DEEPNORM_BETA),
        "mla_w_in": _w(ks[9], (N_MLA, D, mla_cols), D),
        "mla_q_norm_g": 1.0 + 0.02 * jax.random.normal(ks[10], (N_MLA, MLA_Q_RANK), jnp.float32),
        "mla_kv_norm_g": 1.0 + 0.02 * jax.random.normal(ks[11], (N_MLA, MLA_KV_RANK), jnp.float32),
        "mla_w_uq": _w(ks[12], (N_MLA, MLA_Q_RANK, MLA_HEADS * MLA_QK), MLA_Q_RANK),
        "mla_w_ukv": _w(ks[13], (N_MLA, MLA_KV_RANK, MLA_HEADS * (MLA_NOPE + MLA_V)), MLA_KV_RANK),
        "mla_w_out": _w(ks[14], (N_MLA, MLA_HEADS * MLA_V, D), MLA_HEADS * MLA_V, DEEPNORM_BETA),
        "ffn_w_in": _w(ks[15], (DEPTH, D, 2 * FFN_HIDDEN), D),
        "ffn_w_out": _w(ks[16], (DEPTH, FFN_HIDDEN, D), FFN_HIDDEN, DEEPNORM_BETA),
        "ln_g": 1.0 + 0.02 * jax.random.normal(ks[17], (DEPTH, 2, D), jnp.float32),
        "ln_b": 0.02 * jax.random.normal(ks[18], (DEPTH, 2, D), jnp.float32),
    }


def reference(x, gla_w_in, gla_w_gate_up, gla_b_gate, gla_norm_g, gla_w_out,
              rpa_w_in, rpa_rel_bias, rpa_w_out,
              mla_w_in, mla_q_norm_g, mla_kv_norm_g, mla_w_uq, mla_w_ukv, mla_w_out,
              ffn_w_in, ffn_w_out, ln_g, ln_b):
    h = x
    for i in range(DEPTH):
        m, j = i % N_MIXERS, i // N_MIXERS
        if m == 0:
            y = gla_mixer(h, gla_w_in[j], gla_w_gate_up[j], gla_b_gate[j], gla_norm_g[j], gla_w_out[j])
        elif m == 1:
            y = rpa_mixer(h, rpa_w_in[j], rpa_rel_bias[j], rpa_w_out[j])
        else:
            y = mla_mixer(h, mla_w_in[j], mla_q_norm_g[j], mla_kv_norm_g[j],
                          mla_w_uq[j], mla_w_ukv[j], mla_w_out[j])
        h = layer_norm(DEEPNORM_ALPHA * h + y, ln_g[i, 0], ln_b[i, 0])
        h = layer_norm(DEEPNORM_ALPHA * h + swiglu(h, ffn_w_in[i], ffn_w_out[i]), ln_g[i, 1], ln_b[i, 1])
    return h
```

```cpp
#include <hip/hip_runtime.h>
#include <hip/hip_cooperative_groups.h>
#include <cstdint>
#include <cstdio>
#include <cstring>
namespace cg = cooperative_groups;

#define LAS __attribute__((address_space(3)))
#define DI __device__ __forceinline__
typedef unsigned short bf16_t;
typedef short bf16x8 __attribute__((ext_vector_type(8)));
typedef float f32x4 __attribute__((ext_vector_type(4)));
typedef float f32x2 __attribute__((ext_vector_type(2)));
typedef float f32x16 __attribute__((ext_vector_type(16)));
typedef unsigned u32x4 __attribute__((ext_vector_type(4)));
typedef unsigned u32x2 __attribute__((ext_vector_type(2)));
typedef __bf16 bfx2 __attribute__((ext_vector_type(2)));

constexpr int T_ = 32768, S_ = 16384, NCH = 256;
constexpr int FFH = 2816;
constexpr float ALPHA = 1.6817928305074290f;
constexpr float LOG2E = 1.4426950408889634f;
constexpr int NTHR = 512;
constexpr int LDS_BYTES = 155648;

constexpr size_t MiB = 1024 * 1024;
constexpr size_t OFF_COS = 1 * MiB, OFF_SIN = 3 * MiB, OFF_DECAY = 5 * MiB, OFF_STAT = 6 * MiB, OFF_W = 8 * MiB;
constexpr size_t OFF_HB = 106 * MiB, OFF_Y = 170 * MiB, OFF_P = 234 * MiB;
constexpr size_t GP_Q = 0, GP_K = 32 * MiB, GP_KT = 64 * MiB, GP_VT = 96 * MiB, GP_R = 160 * MiB, GP_GL = 224 * MiB;
constexpr size_t RP_Q = 0, RP_K = 64 * MiB, RP_VT = 128 * MiB;
constexpr size_t MP_Q = 0, MP_KN = 96 * MiB, MP_VT = 160 * MiB, MP_KR = 224 * MiB;

struct ConvDesc { int in_idx, K, Nsrc, Npad, perm, tile0; long src_off, dst_off; };
struct Params {
    const float* in[19]; float* out; unsigned char* ws;
    ConvDesc cd[18]; int ncd, conv_tiles;
    long w_gla_in[2], w_gla_out[2], w_rpa_in, w_rpa_out, w_mla_in, w_mla_uq, w_mla_ukv, w_mla_out, w_ffn_in[4], w_ffn_out[4];
};

extern __shared__ __attribute__((aligned(16))) unsigned char smem[];

DI unsigned pk2(float lo, float hi) { f32x2 v = {lo, hi}; bfx2 b = __builtin_convertvector(v, bfx2); return __builtin_bit_cast(unsigned, b); }
DI bf16_t f2bf(float x) { return (bf16_t)(pk2(x, 0.f) & 0xffffu); }
DI float bf2f(unsigned v) { return __uint_as_float(v << 16); }
DI float bflo(unsigned u) { return __uint_as_float(u << 16); }
DI float bfhi(unsigned u) { return __uint_as_float(u & 0xffff0000u); }
DI bf16x8 pack8(float a0, float a1, float a2, float a3, float a4, float a5, float a6, float a7) {
    u32x4 p = {pk2(a0, a1), pk2(a2, a3), pk2(a4, a5), pk2(a6, a7)}; return __builtin_bit_cast(bf16x8, p);
}
#define MFMA32(a, b, c) __builtin_amdgcn_mfma_f32_32x32x16_bf16((a), (b), (c), 0, 0, 0)
DI f32x16 zero16() { f32x16 z; for (int i = 0; i < 16; ++i) z[i] = 0.f; return z; }
DI bf16x8 pack_lo(const f32x16& x) { return pack8(x[0], x[1], x[2], x[3], x[4], x[5], x[6], x[7]); }
DI bf16x8 pack_hi(const f32x16& x) { return pack8(x[8], x[9], x[10], x[11], x[12], x[13], x[14], x[15]); }
DI int phase_tid(int wv) { int z = 0; asm volatile("" : "+s"(wv), "+s"(z)); const int lane = __builtin_amdgcn_mbcnt_hi(~0u, __builtin_amdgcn_mbcnt_lo(~0u, z)); return wv * 64 + lane; }
DI float shx(float v, int m, int lane) { return __int_as_float(__builtin_amdgcn_ds_bpermute((lane ^ m) << 2, __float_as_int(v))); }
DI float xh_max(float v) { const auto r = __builtin_amdgcn_permlane32_swap(__float_as_uint(v), __float_as_uint(v), false, false); return fmaxf(__uint_as_float(r[0]), __uint_as_float(r[1])); }
DI float xh_sum(float v) { const auto r = __builtin_amdgcn_permlane32_swap(__float_as_uint(v), __float_as_uint(v), false, false); return __uint_as_float(r[0]) + __uint_as_float(r[1]); }
DI unsigned char* wsptr(const Params& p) { int z = 0; asm volatile("" : "+s"(z)); return p.ws + z; }
DI float* outptr(const Params& p) { int z = 0; asm volatile("" : "+s"(z)); return p.out + z; }
DI const float* inptr(const Params& p, int i) { asm volatile("" : "+s"(i)); return p.in[i]; }
DI int vcu_of_block() { const int G = gridDim.x, bx = blockIdx.x; return (G % 8 == 0) ? (bx % 8) * (G / 8) + bx / 8 : bx; }

constexpr int BM = 256, BK = 64, HALF = 128, NXCD = 8, WGM = 8, HT = HALF * BK;
DI int lds_byte(int r, int c) { int st = (r >> 4) * 2 + (c >> 5), rr = r & 15, cc = c & 31, ob = rr * 64 + cc * 2; return st * 1024 + (ob ^ (((ob >> 9) & 1) << 5)); }
DI void stage_rc(int b, int& R, int& C) { int st = b / 1024, sb = b % 1024, swz = sb ^ (((sb >> 9) & 1) << 5); R = (st >> 1) * 16 + swz / 64; C = (st & 1) * 32 + (swz % 64) / 2; }

typedef f32x4 AccT[2][2][4][2];

template <class Epi>
DI void gemm_phase(int wv, const bf16_t* __restrict__ A, int lda, const bf16_t* __restrict__ Bt, int ldb, int M, int N, int K, const Epi& epi) {
    LAS unsigned char* lds = (LAS unsigned char*)smem;
    const int tid_ = phase_tid(wv); const int tid = tid_, wid = __builtin_amdgcn_readfirstlane(tid >> 6), lane = tid & 63, wr = wid >> 2, wc = wid & 3, fr = lane & 15, fq = lane >> 4;
    unsigned voffA[2], voffB[2];
#pragma unroll
    for (int i = 0; i < 2; ++i) { int R, C; stage_rc(tid * 16 + i * 8192, R, C); voffA[i] = (unsigned)(R * lda + C) * 2u; voffB[i] = (unsigned)(R * ldb + C) * 2u; }
    const size_t kstep = (size_t)(BK * 2), hstepA = (size_t)HALF * lda * 2, hstepB = (size_t)HALF * ldb * 2;
    const unsigned ldsw = (unsigned)wid * 1024u;
    const int aoff = lds_byte(wr * 64 + fr, fq * 8), boff = lds_byte(wc * 32 + fr, fq * 8);
    constexpr int HTB = HT * 2;
#define SA(b, h) (((b) * 2 + (h)) * HTB)
#define SB(b, h) ((4 + (b) * 2 + (h)) * HTB)
#define STAGE(bufoff, gbase, voff) do { _Pragma("unroll") for (int _i = 0; _i < 2; ++_i) \
    __builtin_amdgcn_global_load_lds((const unsigned*)((const char*)(gbase) + (voff)[_i]), (LAS unsigned*)(lds + (bufoff) + ldsw + _i * 8192), 16, 0, 0); } while (0)
#define LDA(dst, b, h) do { _Pragma("unroll") for (int m = 0; m < 4; ++m) _Pragma("unroll") for (int k = 0; k < 2; ++k) dst[m][k] = *(const LAS bf16x8*)(lds + SA(b, h) + aoff + m * 2048 + k * 1024); } while (0)
#define LDB(dst, b, h) do { _Pragma("unroll") for (int n = 0; n < 2; ++n) _Pragma("unroll") for (int k = 0; k < 2; ++k) dst[n][k] = *(const LAS bf16x8*)(lds + SB(b, h) + boff + n * 2048 + k * 1024); } while (0)
#define MMA(ai, bj, At_, Bt_) do { __builtin_amdgcn_s_setprio(1); _Pragma("unroll") for (int m = 0; m < 4; ++m) _Pragma("unroll") for (int n = 0; n < 2; ++n) _Pragma("unroll") for (int k = 0; k < 2; ++k) \
      acc[ai][bj][m][n] = __builtin_amdgcn_mfma_f32_16x16x32_bf16(Bt_[n][k], At_[m][k], acc[ai][bj][m][n], 0, 0, 0); \
    __builtin_amdgcn_s_setprio(0); } while (0)
#define WAIT_V(n) asm volatile("s_waitcnt vmcnt(" #n ")" ::: "memory")
#define WAIT_L(n) asm volatile("s_waitcnt lgkmcnt(" #n ")" ::: "memory")
#define BAR __builtin_amdgcn_s_barrier()
#define SCHED __builtin_amdgcn_sched_barrier(0)
    const int nM = M / BM, nN = N / BM, nwg = nM * nN, nt = K / BK;
#define UNIT_COORDS(uu, BR, BC) do { int wgid = (uu); \
        { int q = nwg / NXCD, r = nwg % NXCD, xcd = wgid % NXCD, off = wgid / NXCD; wgid = (xcd < r ? xcd * (q + 1) : r * (q + 1) + (xcd - r) * q) + off; } \
        const int nig = WGM * nN, gid = wgid / nig, fm = gid * WGM, gsz = min(nM - fm, WGM); \
        BR = (fm + ((wgid % nig) % gsz)) * BM; BC = ((wgid % nig) / gsz) * BM; } while (0)
    if ((int)blockIdx.x < nwg) {
        int brow, bcol; UNIT_COORDS(blockIdx.x, brow, bcol);
        const char* cA = (const char*)A + (size_t)brow * lda * 2; const char* cB = (const char*)Bt + (size_t)bcol * ldb * 2;
        AccT acc;
#pragma unroll
        for (int a = 0; a < 2; ++a)
#pragma unroll
            for (int b = 0; b < 2; ++b)
#pragma unroll
                for (int m = 0; m < 4; ++m)
#pragma unroll
                    for (int n = 0; n < 2; ++n) acc[a][b][m][n] = (f32x4){0.f, 0.f, 0.f, 0.f};
        bf16x8 At[4][2], B0[2][2], B1[2][2];
        STAGE(SB(0, 0), cB, voffB); STAGE(SB(0, 1), cB + hstepB, voffB); STAGE(SA(0, 0), cA, voffA); STAGE(SA(0, 1), cA + hstepA, voffA);
        if (wr == 1) BAR;
        WAIT_V(2); BAR;
        STAGE(SB(1, 0), cB + kstep, voffB); STAGE(SA(1, 0), cA + kstep, voffA); STAGE(SB(1, 1), cB + hstepB + kstep, voffB);
        WAIT_V(6); BAR;
        for (int u = blockIdx.x;;) {
            const bool has_next = u + (int)gridDim.x < nwg;
            int nbrow = brow, nbcol = bcol;
            if (has_next) UNIT_COORDS(u + gridDim.x, nbrow, nbcol);
            const char* nA = (const char*)A + (size_t)nbrow * lda * 2; const char* nB = (const char*)Bt + (size_t)nbcol * ldb * 2;
#pragma unroll 1
            for (int t = 0; t < nt; t += 2) {
                const bool last = (t == nt - 2);
                const char* a1 = cA + (size_t)(t + 1) * kstep;
                const char* a2 = last ? nA : cA + (size_t)(t + 2) * kstep; const char* b2 = last ? nB : cB + (size_t)(t + 2) * kstep;
                const char* a3 = a2 + kstep; const char* b3 = b2 + kstep;
                LDB(B0, 0, 0); LDB(B1, 0, 1); SCHED; LDA(At, 0, 0); STAGE(SA(1, 1), a1 + hstepA, voffA);
                WAIT_V(8); WAIT_L(0); BAR; MMA(0, 0, At, B0); MMA(0, 1, At, B1); BAR; SCHED;
                LDA(At, 0, 1); STAGE(SB(0, 0), b2, voffB); STAGE(SB(0, 1), b2 + hstepB, voffB); STAGE(SA(0, 0), a2, voffA);
                WAIT_V(8); WAIT_L(0); BAR; MMA(1, 0, At, B0); MMA(1, 1, At, B1); BAR; SCHED;
                LDB(B0, 1, 0); LDB(B1, 1, 1); SCHED; LDA(At, 1, 0); STAGE(SA(0, 1), a2 + hstepA, voffA);
                WAIT_V(8); WAIT_L(0); BAR; MMA(0, 0, At, B0); MMA(0, 1, At, B1); BAR; SCHED;
                LDA(At, 1, 1); STAGE(SB(1, 0), b3, voffB); STAGE(SB(1, 1), b3 + hstepB, voffB); STAGE(SA(1, 0), a3, voffA);
                WAIT_V(8); WAIT_L(0); BAR; MMA(1, 0, At, B0); MMA(1, 1, At, B1); BAR; SCHED;
            }
            if (wr == 0) BAR;
            epi(acc, brow, bcol, wr, wc, fr, fq);
            if (!has_next) break;
#pragma unroll
            for (int a = 0; a < 2; ++a)
#pragma unroll
                for (int b = 0; b < 2; ++b)
#pragma unroll
                    for (int m = 0; m < 4; ++m)
#pragma unroll
                        for (int n = 0; n < 2; ++n) acc[a][b][m][n] = (f32x4){0.f, 0.f, 0.f, 0.f};
            brow = nbrow; bcol = nbcol; cA = nA; cB = nB; u += gridDim.x;
            if (wr == 1) BAR;
        }
        WAIT_V(0);
    }
    __syncthreads();
#undef UNIT_COORDS
}

DI void st_rm_half(const AccT& acc, int bj, bf16_t* O, int ld, int brow, int colbase, float sc, int wr, int wc, int fr, int fq) {
#pragma unroll
    for (int ai = 0; ai < 2; ++ai)
#pragma unroll
        for (int m = 0; m < 4; ++m) {
            const int row = brow + ai * 128 + wr * 64 + m * 16 + fr;
            { const f32x4 v0 = acc[ai][bj][m][0] * sc, v1 = acc[ai][bj][m][1] * sc;
              u32x4 w = {pk2(v0[0], v0[1]), pk2(v0[2], v0[3]), pk2(v1[0], v1[1]), pk2(v1[2], v1[3])};
              *(u32x4*)(O + (long)row * ld + colbase + wc * 32 + fq * 8) = w; }
            asm volatile("" ::: "memory");
        }
}
DI void st_tr_half(const AccT& acc, int bj, bf16_t* VT, int brow, int vcolbase, int wr, int wc, int fr, int fq) {
    const int b = brow / S_, s0 = brow % S_;
#pragma unroll
    for (int ai = 0; ai < 2; ++ai)
#pragma unroll
        for (int m = 0; m < 4; ++m) {
            const int s = s0 + ai * 128 + wr * 64 + m * 16 + fr;
#pragma unroll
            for (int n = 0; n < 2; ++n) {
                const f32x4 v = acc[ai][bj][m][n];
                const int vc = vcolbase + wc * 32 + fq * 8 + n * 4;
                bf16_t* pp = VT + ((long)(b * 1024 + vc)) * S_ + s;
                pp[0] = f2bf(v[0]); pp[(long)S_] = f2bf(v[1]); pp[2L * S_] = f2bf(v[2]); pp[3L * S_] = f2bf(v[3]);
            }
            asm volatile("" ::: "memory");
        }
}

struct EpiGlaIn { bf16_t* Pb; float* GL;
    DI void operator()(const AccT& acc, int brow, int bcol, int wr, int wc, int fr, int fq) const {
        const int pn = bcol >> 8;
        if (pn >= 4 && pn < 8) {
            bf16_t* VT = Pb + GP_VT / 2;
            st_tr_half(acc, 0, VT, brow, bcol - 1024, wr, wc, fr, fq); st_tr_half(acc, 1, VT, brow, bcol - 1024 + 128, wr, wc, fr, fq);
        } else if (pn == 12) {
            if (wc == 0) {
#pragma unroll
                for (int ai = 0; ai < 2; ++ai)
#pragma unroll
                    for (int m = 0; m < 4; ++m) { const int row = brow + ai * 128 + wr * 64 + m * 16 + fr; if (fq < 2) { *(f32x4*)(GL + (long)row * 16 + fq * 8) = acc[ai][0][m][0]; *(f32x4*)(GL + (long)row * 16 + fq * 8 + 4) = acc[ai][0][m][1]; } }
            }
        } else {
            bf16_t* O = Pb + (pn < 2 ? GP_Q / 2 : (pn < 4 ? GP_K / 2 : GP_R / 2));
            const int ld = pn < 4 ? 512 : 1024, cb = pn < 2 ? bcol : (pn < 4 ? bcol - 512 : bcol - 2048);
            st_rm_half(acc, 0, O, ld, brow, cb, 1.f, wr, wc, fr, fq); st_rm_half(acc, 1, O, ld, brow, cb + 128, 1.f, wr, wc, fr, fq);
        }
    }
};
struct EpiRpaIn { bf16_t* Pb; float qscale;
    DI void operator()(const AccT& acc, int brow, int bcol, int wr, int wc, int fr, int fq) const {
        const int pn = bcol >> 8;
        bf16_t* Q = Pb + RP_Q / 2; bf16_t* K = Pb + RP_K / 2; bf16_t* VT = Pb + RP_VT / 2;
        if (pn < 8) { bf16_t* O = pn < 4 ? Q : K; const float sc = pn < 4 ? qscale : 1.f; const int cb = pn < 4 ? bcol : bcol - 1024;
            st_rm_half(acc, 0, O, 1024, brow, cb, sc, wr, wc, fr, fq); st_rm_half(acc, 1, O, 1024, brow, cb + 128, sc, wr, wc, fr, fq); }
        else { st_tr_half(acc, 0, VT, brow, bcol - 2048, wr, wc, fr, fq); st_tr_half(acc, 1, VT, brow, bcol - 2048 + 128, wr, wc, fr, fq); }
    }
};
struct EpiPlain { bf16_t* O; int ld; float sc;
    DI void operator()(const AccT& acc, int brow, int bcol, int wr, int wc, int fr, int fq) const {
        st_rm_half(acc, 0, O, ld, brow, bcol, sc, wr, wc, fr, fq); st_rm_half(acc, 1, O, ld, brow, bcol + 128, sc, wr, wc, fr, fq);
    }
};
struct EpiMlaKv { bf16_t* KN; bf16_t* VT;
    DI void operator()(const AccT& acc, int brow, int bcol, int wr, int wc, int fr, int fq) const {
        const int h = bcol >> 8;
        st_rm_half(acc, 0, KN, 1024, brow, h * 128, 1.f, wr, wc, fr, fq);
        st_tr_half(acc, 1, VT, brow, h * 128, wr, wc, fr, fq);
    }
};
struct EpiSwiglu { bf16_t* Hd;
    DI void operator()(const AccT& acc, int brow, int bcol, int wr, int wc, int fr, int fq) const {
        const int pn = bcol >> 8;
#pragma unroll
        for (int ai = 0; ai < 2; ++ai)
#pragma unroll
            for (int m = 0; m < 4; ++m) {
                const int row = brow + ai * 128 + wr * 64 + m * 16 + fr;
                unsigned wq[4];
#pragma unroll
                for (int n = 0; n < 2; ++n) {
                    const f32x4 gt = acc[ai][0][m][n], up = acc[ai][1][m][n]; float o[4];
#pragma unroll
                    for (int j = 0; j < 4; ++j) { const float x = gt[j]; o[j] = x * __builtin_amdgcn_rcpf(1.f + __expf(-x)) * up[j]; }
                    wq[2 * n] = pk2(o[0], o[1]); wq[2 * n + 1] = pk2(o[2], o[3]);
                }
                *(u32x4*)(Hd + (long)row * FFH + pn * 128 + wc * 32 + fq * 8) = (u32x4){wq[0], wq[1], wq[2], wq[3]};
                asm volatile("" ::: "memory");
            }
    }
};
struct EpiRes { const float* hs; float* out; const float* stat; const float* g; const float* b;
    DI void operator()(const AccT& acc, int brow, int bcol, int wr, int wc, int fr, int fq) const {
        const bool norm = stat != nullptr;
        f32x4 gv[2][2], bv[2][2];
#pragma unroll
        for (int bj = 0; bj < 2; ++bj)
#pragma unroll
            for (int n = 0; n < 2; ++n) {
                const int col = bcol + bj * 128 + wc * 32 + fq * 8 + n * 4;
                gv[bj][n] = norm ? *(const f32x4*)(g + col) : (f32x4){1.f, 1.f, 1.f, 1.f};
                bv[bj][n] = norm ? *(const f32x4*)(b + col) : (f32x4){0.f, 0.f, 0.f, 0.f};
            }
#pragma unroll
        for (int ai = 0; ai < 2; ++ai) {
#pragma unroll
            for (int mh = 0; mh < 2; ++mh) {
                f32x4 hv[2][2][2]; f32x2 sv[2];
#pragma unroll
                for (int mm = 0; mm < 2; ++mm) {
                    const int m = mh * 2 + mm;
                    const int row = brow + ai * 128 + wr * 64 + m * 16 + fr;
                    sv[mm] = norm ? *(const f32x2*)(stat + (long)row * 2) : (f32x2){0.f, 1.f};
#pragma unroll
                    for (int bj = 0; bj < 2; ++bj)
#pragma unroll
                        for (int n = 0; n < 2; ++n) hv[mm][bj][n] = *(const f32x4*)(hs + (long)row * 1024 + bcol + bj * 128 + wc * 32 + fq * 8 + n * 4);
                }
#pragma unroll
                for (int mm = 0; mm < 2; ++mm) {
                    const int m = mh * 2 + mm;
                    const int row = brow + ai * 128 + wr * 64 + m * 16 + fr;
                    const float ra = sv[mm][1], rc = -sv[mm][0] * sv[mm][1];
#pragma unroll
                    for (int bj = 0; bj < 2; ++bj)
#pragma unroll
                        for (int n = 0; n < 2; ++n) {
                            const f32x4 hn = (hv[mm][bj][n] * ra + rc) * gv[bj][n] + bv[bj][n];
                            *(f32x4*)(out + (long)row * 1024 + bcol + bj * 128 + wc * 32 + fq * 8 + n * 4) = hn * ALPHA + acc[ai][bj][m][n];
                        }
                }
                asm volatile("" ::: "memory");
            }
        }
    }
};

constexpr size_t OFF_LNX = 464 * MiB;
constexpr size_t OFF_LNC = 32768;
struct EpiResLN { static constexpr int NVM = 0;
    const float* hs; float* outh; bf16_t* outb; const float* g; const float* b; unsigned long long* xbuf; unsigned* cnt;
    DI void operator()(const AccT& acc, int brow, int bcol, int wr, int wc, int fr, int fq) const {
        AccT z;
        LAS unsigned char* lds = (LAS unsigned char*)smem;
        LAS f32x2* P = (LAS f32x2*)(lds + 131072);
        LAS f32x2* Tb = (LAS f32x2*)(lds + 131072 + 8192);
        const int lane = fq * 16 + fr, tid = (wr * 4 + wc) * 64 + lane;
        const int pm = brow >> 8, pn = bcol >> 8;
#pragma unroll
        for (int ai = 0; ai < 2; ++ai)
#pragma unroll
            for (int m = 0; m < 4; ++m) {
                const int row = brow + ai * 128 + wr * 64 + m * 16 + fr;
                const float* hp = hs + (long)row * 1024 + bcol + wc * 32 + fq * 8;
                float sm = 0.f, sq = 0.f;
#pragma unroll
                for (int bj = 0; bj < 2; ++bj)
#pragma unroll
                    for (int n = 0; n < 2; ++n) {
                        const f32x4 hv = *(const f32x4*)(hp + bj * 128 + n * 4);
                        const f32x4 v = hv * ALPHA + acc[ai][bj][m][n];
                        z[ai][bj][m][n] = v;
                        sm += (v[0] + v[1]) + (v[2] + v[3]); sq += (v[0] * v[0] + v[1] * v[1]) + (v[2] * v[2] + v[3] * v[3]);
                    }
                sm += shx(sm, 16, lane); sq += shx(sq, 16, lane); sm += shx(sm, 32, lane); sq += shx(sq, 32, lane);
                if (fq == 0) P[(ai * 128 + wr * 64 + m * 16 + fr) * 4 + wc] = (f32x2){sm, sq};
                if (m & 1) asm volatile("" ::: "memory");
            }
        __syncthreads();
        if (tid < 256) {
            float sm = 0.f, sq = 0.f;
#pragma unroll
            for (int k = 0; k < 4; ++k) { const f32x2 v = P[tid * 4 + k]; sm += v[0]; sq += v[1]; }
            const unsigned long long pk = (unsigned long long)__float_as_uint(sm) | ((unsigned long long)__float_as_uint(sq) << 32);
            __hip_atomic_store(xbuf + ((long)(pm * 4 + pn) * 256 + tid), pk, __ATOMIC_RELAXED, __HIP_MEMORY_SCOPE_AGENT);
        }
        asm volatile("s_waitcnt vmcnt(0)" ::: "memory");
        __syncthreads();
        if (tid == 0) {
            unsigned* c = cnt + pm * 16;
            __hip_atomic_fetch_add(c, 1u, __ATOMIC_RELAXED, __HIP_MEMORY_SCOPE_AGENT);
            unsigned sp = 0;
            while (__hip_atomic_load(c, __ATOMIC_RELAXED, __HIP_MEMORY_SCOPE_AGENT) < 4u) { __builtin_amdgcn_s_sleep(1); if (++sp > (1u << 22)) break; }
        }
        __syncthreads();
        if (tid < 256) {
            float sm = 0.f, sq = 0.f;
#pragma unroll
            for (int k = 0; k < 4; ++k) {
                const unsigned long long v = __hip_atomic_load(xbuf + ((long)(pm * 4 + k) * 256 + tid), __ATOMIC_RELAXED, __HIP_MEMORY_SCOPE_AGENT);
                sm += __uint_as_float((unsigned)(v & 0xffffffffull)); sq += __uint_as_float((unsigned)(v >> 32));
            }
            const float mu = sm * (1.f / 1024.f), var = fmaxf(sq * (1.f / 1024.f) - mu * mu, 0.f);
            Tb[tid] = (f32x2){mu, 1.0f / sqrtf(var + 1e-5f)};
        }
        __syncthreads();
        f32x4 gv[2][2], bv[2][2];
#pragma unroll
        for (int bj = 0; bj < 2; ++bj)
#pragma unroll
            for (int n = 0; n < 2; ++n) { const int col = bcol + bj * 128 + wc * 32 + fq * 8 + n * 4; gv[bj][n] = *(const f32x4*)(g + col); bv[bj][n] = *(const f32x4*)(b + col); }
#pragma unroll
        for (int ai = 0; ai < 2; ++ai)
#pragma unroll
            for (int m = 0; m < 4; ++m) {
                const int rl = ai * 128 + wr * 64 + m * 16 + fr; const long row = brow + rl;
                const f32x2 t = Tb[rl]; const float ra = t[1], rc = -t[0] * t[1];
#pragma unroll
                for (int bj = 0; bj < 2; ++bj) {
                    const f32x4 y0 = (z[ai][bj][m][0] * ra + rc) * gv[bj][0] + bv[bj][0], y1 = (z[ai][bj][m][1] * ra + rc) * gv[bj][1] + bv[bj][1];
                    const long idx = row * 1024 + bcol + bj * 128 + wc * 32 + fq * 8;
                    *(f32x4*)(outh + idx) = y0; *(f32x4*)(outh + idx + 4) = y1;
                    *(u32x4*)(outb + idx) = (u32x4){pk2(y0[0], y0[1]), pk2(y0[2], y0[3]), pk2(y1[0], y1[1]), pk2(y1[2], y1[3])};
                }
                asm volatile("" ::: "memory");
            }
        __syncthreads();
    }
};

DI void phase_convert(const Params& p, int wv) {
    bf16_t* W = (bf16_t*)(wsptr(p) + OFF_W);
    LAS bf16_t* tile = (LAS bf16_t*)smem;
    const int tid_ = phase_tid(wv); const int tid = tid_;
    for (int t4 = blockIdx.x * 4; t4 < p.conv_tiles; t4 += gridDim.x * 4) {
        int di = 0;
#pragma unroll 1
        for (int i = 1; i < 18; ++i) { int ii = i; asm volatile("" : "+s"(ii)); if (t4 >= p.cd[ii].tile0) di = ii; }
        asm volatile("" : "+s"(di));
        const int K = p.cd[di].K, Nsrc = p.cd[di].Nsrc, perm = p.cd[di].perm, tile0 = p.cd[di].tile0, in_idx = p.cd[di].in_idx;
        const float* src = inptr(p, in_idx) + p.cd[di].src_off;
        bf16_t* dst = W + p.cd[di].dst_off;
        const int ntk = K / 64;
        const int kl = tid >> 4, n4 = (tid & 15) * 4;
        f32x4 v[4][2];
#pragma unroll
        for (int j = 0; j < 4; ++j) {
            const int lt = t4 + j - tile0, kt = lt % ntk, ntile = lt / ntk, k0 = kt * 64, n0 = ntile * 64;
            const int sc0 = perm ? ((n0 & 255) >> 7) * FFH + (n0 >> 8) * 128 + (n0 & 127) : n0;
#pragma unroll
            for (int i = 0; i < 2; ++i) {
                const int k = k0 + kl + 32 * i;
                v[j][i] = (f32x4){0.f, 0.f, 0.f, 0.f};
                if (sc0 + n4 < Nsrc) v[j][i] = *(const f32x4*)(src + (long)k * Nsrc + sc0 + n4);
            }
        }
#pragma unroll
        for (int j = 0; j < 4; ++j)
#pragma unroll
            for (int i = 0; i < 2; ++i)
#pragma unroll
                for (int e = 0; e < 4; ++e) { const int c64 = n4 + e, c = c64 & 31, slot = (c64 & 32) + 16 * ((c >> 2) & 1) + 4 * (c >> 3) + (c & 3); tile[j * 4608 + slot * 72 + kl + 32 * i] = f2bf(v[j][i][e]); }
        __syncthreads();
#pragma unroll
        for (int j = 0; j < 4; ++j) {
            const int lt = t4 + j - tile0, kt = lt % ntk, ntile = lt / ntk, k0 = kt * 64, n0 = ntile * 64;
            const int n = tid >> 3, kc = (tid & 7) * 8;
            const u32x4 w = *(const LAS u32x4*)(tile + j * 4608 + n * 72 + kc);
            *(u32x4*)(dst + (long)(n0 + n) * K + k0 + kc) = w;
        }
        __syncthreads();
    }
    { const float* x = inptr(p, 0); bf16_t* hb = (bf16_t*)(wsptr(p) + OFF_HB);
      const long n8 = (long)T_ * 1024 / 8;
      for (long i = (long)blockIdx.x * NTHR + tid; i < n8; i += (long)gridDim.x * NTHR) {
          const f32x4 a = *(const f32x4*)(x + i * 8), b = *(const f32x4*)(x + i * 8 + 4);
          u32x4 w = {pk2(a[0], a[1]), pk2(a[2], a[3]), pk2(b[0], b[1]), pk2(b[2], b[3])};
          *(u32x4*)(hb + i * 8) = w;
      } }
    { float* ct = (float*)(wsptr(p) + OFF_COS); float* st = (float*)(wsptr(p) + OFF_SIN);
      const float inv = (float)pow(10000.0, -(double)(tid & 31) / 32.0);
      for (int i = blockIdx.x * NTHR + tid; i < S_ * 32; i += gridDim.x * NTHR) {
          const int pos = i >> 5;
          const float ang = (float)pos * inv;
          float sv, cv; sincosf(ang, &sv, &cv); ct[i] = cv; st[i] = sv;
      } }
}

DI void phase_ln(int wv, const float* h, float* hout, bf16_t* hb, float* stat, const float* g, const float* bt, bool final_out) {
    const int tid_ = phase_tid(wv); const int tid = tid_, wid = tid >> 6, lane = tid & 63;
    const int nw = gridDim.x * 8;
    f32x4 gv[4], bv[4];
#pragma unroll
    for (int i = 0; i < 4; ++i) { gv[i] = *(const f32x4*)(g + i * 256 + lane * 4); bv[i] = *(const f32x4*)(bt + i * 256 + lane * 4); }
    for (int row = blockIdx.x * 8 + wid; row < T_; row += nw) {
        f32x4 v[4]; float s = 0.f;
#pragma unroll
        for (int i = 0; i < 4; ++i) { v[i] = *(const f32x4*)(h + (long)row * 1024 + i * 256 + lane * 4); s += (v[i][0] + v[i][1]) + (v[i][2] + v[i][3]); }
#pragma unroll
        for (int o = 32; o >= 1; o >>= 1) s += shx(s, o, lane);
        const float mu = s * (1.f / 1024.f); float q = 0.f;
#pragma unroll
        for (int i = 0; i < 4; ++i) { const f32x4 d = v[i] - mu; q += (d[0] * d[0] + d[1] * d[1]) + (d[2] * d[2] + d[3] * d[3]); }
#pragma unroll
        for (int o = 32; o >= 1; o >>= 1) q += shx(q, o, lane);
        const float rstd = 1.0f / sqrtf(q * (1.f / 1024.f) + 1e-5f);
        const float ra = rstd, rc = -mu * rstd;
        if (final_out) {
#pragma unroll
            for (int i = 0; i < 4; ++i) *(f32x4*)(hout + (long)row * 1024 + i * 256 + lane * 4) = (v[i] * ra + rc) * gv[i] + bv[i];
        } else {
            if (lane == 0) *(f32x2*)(stat + (long)row * 2) = (f32x2){mu, rstd};
#pragma unroll
            for (int i = 0; i < 4; ++i) {
                const f32x4 y = (v[i] * ra + rc) * gv[i] + bv[i];
                u32x2 w = {pk2(y[0], y[1]), pk2(y[2], y[3])};
                *(u32x2*)(hb + (long)row * 1024 + i * 256 + lane * 4) = w;
            }
        }
    }
}

DI void phase_mla_norm(const Params& p, int wv) {
    const int tid_ = phase_tid(wv); const int tid = tid_, wid = tid >> 6, lane = tid & 63;
    bf16_t* C = (bf16_t*)(wsptr(p) + OFF_Y);
    bf16_t* KR = (bf16_t*)(wsptr(p) + OFF_P + MP_KR);
    const float* ct = (const float*)(wsptr(p) + OFF_COS); const float* st = (const float*)(wsptr(p) + OFF_SIN);
    const float* gq = inptr(p, 10); const float* gkv = inptr(p, 11);
    float gqv[6], gkvv[4];
#pragma unroll
    for (int e = 0; e < 6; ++e) gqv[e] = gq[lane * 6 + e];
#pragma unroll
    for (int e = 0; e < 4; ++e) gkvv[e] = gkv[lane * 4 + e];
    const int nw = gridDim.x * 8;
    for (int row = blockIdx.x * 8 + wid; row < T_; row += nw) {
        bf16_t* cr = C + (long)row * 768;
        unsigned* cq = (unsigned*)(cr + lane * 6);
        const unsigned q0 = cq[0], q1 = cq[1], q2 = cq[2];
        float xq[6] = {bflo(q0), bfhi(q0), bflo(q1), bfhi(q1), bflo(q2), bfhi(q2)};
        u32x2* ck = (u32x2*)(cr + 384 + lane * 4);
        const u32x2 kk = *ck;
        float xk[4] = {bflo(kk[0]), bfhi(kk[0]), bflo(kk[1]), bfhi(kk[1])};
        const float tr = bf2f(cr[640 + lane]);
        float sq = 0.f, sk = 0.f;
#pragma unroll
        for (int e = 0; e < 6; ++e) sq += xq[e] * xq[e];
#pragma unroll
        for (int e = 0; e < 4; ++e) sk += xk[e] * xk[e];
#pragma unroll
        for (int o = 32; o >= 1; o >>= 1) { sq += shx(sq, o, lane); sk += shx(sk, o, lane); }
        const float rq = 1.0f / sqrtf(sq * (1.f / 384.f) + 1e-6f), rk = 1.0f / sqrtf(sk * (1.f / 256.f) + 1e-6f);
        cq[0] = pk2(xq[0] * rq * gqv[0], xq[1] * rq * gqv[1]);
        cq[1] = pk2(xq[2] * rq * gqv[2], xq[3] * rq * gqv[3]);
        cq[2] = pk2(xq[4] * rq * gqv[4], xq[5] * rq * gqv[5]);
        u32x2 w = {pk2(xk[0] * rk * gkvv[0], xk[1] * rk * gkvv[1]), pk2(xk[2] * rk * gkvv[2], xk[3] * rk * gkvv[3])};
        *ck = w;
        const float pr = shx(tr, 32, lane);
        const int pos = row % S_, f = lane & 31;
        const float c = ct[pos * 32 + f], s = st[pos * 32 + f];
        const float o = (lane < 32) ? (tr * c - pr * s) : (pr * s + tr * c);
        KR[(long)row * 64 + lane] = f2bf(o);
    }
}

constexpr int MK_STR = 400, MV_STR = 144, MK_BYTES = 64 * MK_STR, MV_BYTES = 128 * MV_STR;
constexpr int MV_BASE = 2 * MK_BYTES, MQR_BASE = MV_BASE + 3 * MV_BYTES;
DI void phase_mla_attn(const Params& p, int wv) {
    LAS unsigned char* lds = (LAS unsigned char*)smem;
    const bf16_t* Q = (const bf16_t*)(wsptr(p) + OFF_P + MP_Q); const bf16_t* KN = (const bf16_t*)(wsptr(p) + OFF_P + MP_KN);
    const bf16_t* VT = (const bf16_t*)(wsptr(p) + OFF_P + MP_VT); const bf16_t* KR = (const bf16_t*)(wsptr(p) + OFF_P + MP_KR);
    bf16_t* Y = (bf16_t*)(wsptr(p) + OFF_Y);
    const float* ct = (const float*)(wsptr(p) + OFF_COS); const float* st = (const float*)(wsptr(p) + OFF_SIN);
    const int tid_ = phase_tid(wv); const int tid = tid_, wid = __builtin_amdgcn_readfirstlane(tid >> 6), lane = tid & 63, l32 = lane & 31, g = lane >> 5;
    const int G = gridDim.x, vcu = vcu_of_block();
    const bool grpB = wid >= 4;
    for (int pi = vcu; pi < 512; pi += G) {
        const int bh = pi >> 5, pp = pi & 31, b = bh >> 3, h = bh & 7;
        for (int half = 0; half < 2; ++half) {
            const int qt = half ? pp : (63 - pp);
            const int cq = qt * 4 + (wid >> 1), ntiles = qt * 4 + 4;
            bf16x8 q[6];
            LAS unsigned char* qr = lds + MQR_BASE + wid * 6144 + lane * 16;
            { const char* qpb = (const char*)(Q + ((long)b * S_ + qt * 256) * 1536 + h * 192);
              const unsigned qoff = (unsigned)((wid * 32 + l32) * 1536 + g * 8) * 2u;
              bf16x8 qro[4];
#pragma unroll
              for (int s = 0; s < 4; ++s) qro[s] = *(const bf16x8*)(qpb + qoff + 32 * (8 + s));
#pragma unroll
              for (int s = 0; s < 6; ++s) q[s] = *(const bf16x8*)(qpb + qoff + 32 * s);
#pragma unroll
              for (int s = 6; s < 8; ++s) *(LAS bf16x8*)(qr + (s - 2) * 1024) = *(const bf16x8*)(qpb + qoff + 32 * s);
              const char* ctb = (const char*)(ct + (long)qt * 256 * 32); const char* stb = (const char*)(st + (long)qt * 256 * 32);
              const unsigned toff = (unsigned)((wid * 32 + l32) * 32 + 8 * g) * 4u;
#pragma unroll
              for (int ss = 0; ss < 2; ++ss) {
                  const f32x4 c0 = *(const f32x4*)(ctb + toff + 64 * ss), c1 = *(const f32x4*)(ctb + toff + 64 * ss + 16);
                  const f32x4 s0 = *(const f32x4*)(stb + toff + 64 * ss), s1 = *(const f32x4*)(stb + toff + 64 * ss + 16);
                  float o1[8], o2[8];
#pragma unroll
                  for (int e = 0; e < 8; ++e) {
                      const float c = e < 4 ? c0[e & 3] : c1[e & 3], s = e < 4 ? s0[e & 3] : s1[e & 3];
                      const float t1 = bf2f((unsigned short)qro[ss][e]), t2 = bf2f((unsigned short)qro[2 + ss][e]);
                      o1[e] = t1 * c - t2 * s; o2[e] = t1 * s + t2 * c;
                  }
                  *(LAS bf16x8*)(qr + ss * 1024) = pack8(o1[0], o1[1], o1[2], o1[3], o1[4], o1[5], o1[6], o1[7]);
                  *(LAS bf16x8*)(qr + (2 + ss) * 1024) = pack8(o2[0], o2[1], o2[2], o2[3], o2[4], o2[5], o2[6], o2[7]);
              } }
            f32x16 o[4]; for (int i = 0; i < 4; ++i) o[i] = zero16();
            float mrun = -1e30f, lsum = 0.f;
            u32x4 kreg[3], vreg[2];
            const long key_base = (long)b * S_;
            const unsigned kn_off = (unsigned)((tid >> 4) * 1024 + (tid & 15) * 8) * 2u, kr_off = (unsigned)((tid >> 3) * 64 + (tid & 7) * 8) * 2u, vt_off = (unsigned)((tid >> 3) * S_ + (tid & 7) * 8) * 2u;
#define MLA_GLOAD(kt) do { const long k0 = key_base + (long)(kt) * 64; \
    const char* knb = (const char*)(KN + k0 * 1024 + h * 128); const char* krb = (const char*)(KR + k0 * 64); \
    const char* vtb = (const char*)(VT + ((long)(b * 1024 + h * 128)) * S_ + (long)(kt) * 64); \
    kreg[0] = *(const u32x4*)(knb + kn_off); kreg[1] = *(const u32x4*)(knb + 65536 + kn_off); \
    kreg[2] = *(const u32x4*)(krb + kr_off); \
    vreg[0] = *(const u32x4*)(vtb + vt_off); vreg[1] = *(const u32x4*)(vtb + 64L * S_ * 2 + vt_off); } while (0)
#define MLA_LWRITE(kbufp, vbufp) do { LAS unsigned char* _kp = (kbufp); LAS unsigned char* _vp = (vbufp); \
    { const int id = tid; *(LAS u32x4*)(_kp + (id >> 4) * MK_STR + (id & 15) * 16) = kreg[0]; } \
    { const int id = tid + 512; *(LAS u32x4*)(_kp + (id >> 4) * MK_STR + (id & 15) * 16) = kreg[1]; } \
    *(LAS u32x4*)(_kp + (tid >> 3) * MK_STR + 256 + (tid & 7) * 16) = kreg[2]; \
    { const int id = tid; *(LAS u32x4*)(_vp + (id >> 3) * MV_STR + (id & 7) * 16) = vreg[0]; } \
    { const int id = tid + 512; *(LAS u32x4*)(_vp + (id >> 3) * MV_STR + (id & 7) * 16) = vreg[1]; } } while (0)
            auto do_qk = [&](f32x16& s0, f32x16& s1, LAS unsigned char* kbuf) {
                s0 = zero16(); s1 = zero16();
                LAS unsigned char* kb = kbuf + ((l32 & 19) | ((l32 & 4) << 1) | ((l32 & 8) >> 1)) * MK_STR + g * 16;
                __builtin_amdgcn_s_setprio(1);
#pragma unroll
                for (int s = 0; s < 12; ++s) {
                    const bf16x8 a0 = *(const LAS bf16x8*)(kb + s * 32), a1 = *(const LAS bf16x8*)(kb + 32 * MK_STR + s * 32);
                    const bf16x8 qv = (s < 6) ? q[s < 6 ? s : 0] : *(const LAS bf16x8*)(qr + (s < 8 ? s - 2 : s - 8) * 1024);
                    s0 = MFMA32(a0, qv, s0); s1 = MFMA32(a1, qv, s1);
                }
                __builtin_amdgcn_s_setprio(0);
            };
            auto do_sm_pv = [&](f32x16& s0, f32x16& s1, LAS unsigned char* vbuf) {
                float mx = s0[0];
#pragma unroll
                for (int i = 0; i < 16; ++i) { mx = fmaxf(mx, s0[i]); mx = fmaxf(mx, s1[i]); }
                mx = xh_max(mx);
                const bool fire = __builtin_amdgcn_ballot_w64(mx - mrun > 8.0f) != 0ull;
                const float mnew = fire ? fmaxf(mrun, mx) : mrun, alpha = __builtin_amdgcn_exp2f(mrun - mnew);
                mrun = mnew;
                float ps = 0.f;
#pragma unroll
                for (int i = 0; i < 16; ++i) { s0[i] = __builtin_amdgcn_exp2f(s0[i] - mnew); s1[i] = __builtin_amdgcn_exp2f(s1[i] - mnew); ps += s0[i] + s1[i]; }
                lsum = lsum * alpha + ps;
                if (fire) {
#pragma unroll
                    for (int t = 0; t < 4; ++t) o[t] = o[t] * alpha;
                }
                bf16x8 pb[4] = {pack_lo(s0), pack_hi(s0), pack_lo(s1), pack_hi(s1)};
                LAS unsigned char* vb = vbuf + l32 * MV_STR + g * 16;
                __builtin_amdgcn_s_setprio(1);
#pragma unroll
                for (int dvt = 0; dvt < 4; ++dvt)
#pragma unroll
                    for (int ss = 0; ss < 4; ++ss) {
                        const bf16x8 a8 = *(const LAS bf16x8*)(vb + dvt * 32 * MV_STR + ss * 32);
                        o[dvt] = MFMA32(a8, pb[ss], o[dvt]);
                    }
                __builtin_amdgcn_s_setprio(0);
            };
            const bool rev = half != 0;
#define KT(i) (rev ? (ntiles - 1 - (i)) : (i))
            MLA_GLOAD(KT(0)); MLA_LWRITE(lds, lds + MV_BASE); __syncthreads();
            if (!grpB) {
                int vcur = 0;
                for (int i = 0; i < ntiles; ++i) {
                    const int vnext = vcur == 2 ? 0 : vcur + 1;
                    if (i + 1 < ntiles) MLA_GLOAD(KT(i + 1));
                    if (KT(i) <= cq) { f32x16 s0, s1; do_qk(s0, s1, lds + (i & 1) * MK_BYTES); do_sm_pv(s0, s1, lds + MV_BASE + vcur * MV_BYTES); }
                    if (i + 1 < ntiles) MLA_LWRITE(lds + ((i + 1) & 1) * MK_BYTES, lds + MV_BASE + vnext * MV_BYTES);
                    __syncthreads();
                    vcur = vnext;
                }
            } else {
                int vcur = 0;
                f32x16 s0 = zero16(), s1 = zero16();
                for (int i = 0; i < ntiles; ++i) {
                    const int vprev = vcur == 0 ? 2 : vcur - 1, vnext = vcur == 2 ? 0 : vcur + 1;
                    if (i + 1 < ntiles) MLA_GLOAD(KT(i + 1));
                    if (i >= 1 && KT(i - 1) <= cq) do_sm_pv(s0, s1, lds + MV_BASE + vprev * MV_BYTES);
                    if (KT(i) <= cq) do_qk(s0, s1, lds + (i & 1) * MK_BYTES);
                    if (i + 1 < ntiles) MLA_LWRITE(lds + ((i + 1) & 1) * MK_BYTES, lds + MV_BASE + vnext * MV_BYTES);
                    __syncthreads();
                    vcur = vnext;
                }
                if (KT(ntiles - 1) <= cq) { const int vlast = vcur == 0 ? 2 : vcur - 1; do_sm_pv(s0, s1, lds + MV_BASE + vlast * MV_BYTES); }
            }
#undef KT
            const float ltot = xh_sum(lsum), inv = 1.f / ltot;
            char* ypb = (char*)(Y + ((long)b * S_ + qt * 256) * 1024 + h * 128);
            const unsigned yoff = (unsigned)((wid * 32 + l32) * 1024 + 4 * g) * 2u;
#pragma unroll
            for (int dvt = 0; dvt < 4; ++dvt)
#pragma unroll
                for (int a = 0; a < 4; ++a) {
                    u32x2 w = {pk2(o[dvt][4 * a] * inv, o[dvt][4 * a + 1] * inv), pk2(o[dvt][4 * a + 2] * inv, o[dvt][4 * a + 3] * inv)};
                    *(u32x2*)(ypb + yoff + (dvt * 32 + a * 8) * 2) = w;
                }
            __syncthreads();
        }
    }
#undef MLA_GLOAD
#undef MLA_LWRITE
}

constexpr int RK_STR = 144, RV_STR = 136, RK_BYTES = 64 * RK_STR, RV_BYTES = 64 * RV_STR, RBUF = RK_BYTES + RV_BYTES, R_BIAS_OFF = 3 * RBUF;
DI void phase_rpa_attn(const Params& p, int wv) {
    LAS unsigned char* lds = (LAS unsigned char*)smem;
    const bf16_t* Q = (const bf16_t*)(wsptr(p) + OFF_P + RP_Q); const bf16_t* Kp = (const bf16_t*)(wsptr(p) + OFF_P + RP_K);
    const bf16_t* VT = (const bf16_t*)(wsptr(p) + OFF_P + RP_VT);
    bf16_t* Y = (bf16_t*)(wsptr(p) + OFF_Y);
    const float* relb = inptr(p, 7);
    LAS float* bias = (LAS float*)(lds + R_BIAS_OFF);
    const int tid_ = phase_tid(wv); const int tid = tid_, wid = __builtin_amdgcn_readfirstlane(tid >> 6), lane = tid & 63, l32 = lane & 31, g = lane >> 5;
    const int G = gridDim.x, vcu = vcu_of_block();
    u32x4 kreg0, vreg0, kreg1, vreg1;
    bf16x8 qn[4]; bool pre = false;
    for (int u = vcu; u < 2048; u += G) {
        const int bh = u >> 6, grp = u & 63, b = bh >> 4, h = bh & 15;
        const int c = grp * 4 + (wid >> 1);
        const int qi = (wid & 1) * 32 + l32;
        const long tok = (long)b * S_ + c * 64 + qi;
        bf16x8 q[4];
        if (pre) {
#pragma unroll
            for (int s = 0; s < 4; ++s) q[s] = qn[s];
        } else { const bf16_t* qp = Q + tok * 1024 + h * 64 + g * 8;
#pragma unroll
          for (int s = 0; s < 4; ++s) q[s] = *(const bf16x8*)(qp + 16 * s); }
        const bool has_next = u + G < 2048;
        const int un = u + G, bhn = un >> 6, grpn = un & 63, bn = bhn >> 4, hn = bhn & 15, kc0n = max(0, grpn * 4 - 8);
        if (tid < 257) bias[tid] = relb[h * 257 + tid] * LOG2E;
        f32x16 o[2] = {zero16(), zero16()};
        float mrun = -1e30f, lsum = 0.f;
        const unsigned rk_off = (unsigned)((tid >> 3) * 1024 + (tid & 7) * 8) * 2u, rv_off = (unsigned)((tid >> 3) * S_ + (tid & 7) * 8) * 2u;
        const int kc0 = max(0, grp * 4 - 8), kc1 = grp * 4 + 3, ntl = kc1 - kc0 + 1;
#define RPA_GLOADX(bb, hh, kc, KR_, VR_) do { const long k0 = (long)(bb) * S_ + (long)(kc) * 64; \
    const char* kb_ = (const char*)(Kp + k0 * 1024 + (hh) * 64); const char* vtb = (const char*)(VT + ((long)((bb) * 1024 + (hh) * 64)) * S_ + (long)(kc) * 64); \
    KR_ = *(const u32x4*)(kb_ + rk_off); VR_ = *(const u32x4*)(vtb + rv_off); } while (0)
#define RPA_GLOAD(kc, KR_, VR_) RPA_GLOADX(b, h, kc, KR_, VR_)
#define RPA_LWRITE(bufp, KR_, VR_) do { LAS unsigned char* _bp = (bufp); \
    *(LAS u32x4*)(_bp + (tid >> 3) * RK_STR + (tid & 7) * 16) = KR_; \
    { LAS unsigned char* a = _bp + RK_BYTES + (tid >> 3) * RV_STR + (tid & 7) * 16; \
      *(LAS u32x2*)a = (u32x2){VR_[0], VR_[1]}; *(LAS u32x2*)(a + 8) = (u32x2){VR_[2], VR_[3]}; } } while (0)
        auto tile = [&](int kc, LAS unsigned char* buf) {
            if (kc <= c && kc >= c - 8) {
                f32x16 s0 = zero16(), s1 = zero16();
                LAS unsigned char* kb = buf + l32 * RK_STR + g * 16;
#pragma unroll
                for (int s = 0; s < 4; ++s) {
                    const bf16x8 a0 = *(const LAS bf16x8*)(kb + s * 32), a1 = *(const LAS bf16x8*)(kb + 32 * RK_STR + s * 32);
                    s0 = MFMA32(a0, q[s], s0); s1 = MFMA32(a1, q[s], s1);
                }
                const int dist = c - kc;
                if (dist >= 3) {
                    const float bc = bias[256];
#pragma unroll
                    for (int i = 0; i < 16; ++i) { s0[i] += bc; s1[i] += bc; }
                } else {
                    const int base = dist * 64 + qi - 4 * g;
#pragma unroll
                    for (int i = 0; i < 16; ++i) {
                        const int kj = 8 * (i >> 2) + (i & 3);
                        const int r0 = base - kj, r1 = base - kj - 32;
                        s0[i] += bias[min(r0, 128) + 128]; s1[i] += bias[min(r1, 128) + 128];
                    }
                }
                float mx = s0[0];
#pragma unroll
                for (int i = 0; i < 16; ++i) { mx = fmaxf(mx, s0[i]); mx = fmaxf(mx, s1[i]); }
                mx = xh_max(mx);
                if (__builtin_amdgcn_ballot_w64(mx - mrun > 8.0f) != 0ull) {
                    const float mnew = fmaxf(mrun, mx), alpha = __builtin_amdgcn_exp2f(mrun - mnew); mrun = mnew;
                    lsum *= alpha; o[0] = o[0] * alpha; o[1] = o[1] * alpha;
                }
                float ps = 0.f;
#pragma unroll
                for (int i = 0; i < 16; ++i) { s0[i] = __builtin_amdgcn_exp2f(s0[i] - mrun); s1[i] = __builtin_amdgcn_exp2f(s1[i] - mrun); ps += s0[i] + s1[i]; }
                lsum += ps;
                bf16x8 pb[4] = {pack_lo(s0), pack_hi(s0), pack_lo(s1), pack_hi(s1)};
                LAS unsigned char* vb = buf + RK_BYTES + l32 * RV_STR + g * 8;
#pragma unroll
                for (int dvt = 0; dvt < 2; ++dvt)
#pragma unroll
                    for (int ss = 0; ss < 4; ++ss) {
                        const u32x2 lo = *(const LAS u32x2*)(vb + dvt * 32 * RV_STR + ss * 32), hi = *(const LAS u32x2*)(vb + dvt * 32 * RV_STR + ss * 32 + 16);
                        u32x4 a4 = {lo[0], lo[1], hi[0], hi[1]};
                        o[dvt] = MFMA32(__builtin_bit_cast(bf16x8, a4), pb[ss], o[dvt]);
                    }
            }
        };
        if (!pre) { RPA_GLOAD(kc0, kreg0, vreg0); RPA_GLOAD(kc0 + 1, kreg1, vreg1); }
        RPA_LWRITE(lds, kreg0, vreg0); __syncthreads();
        int slot = 0;
        for (int it = 0; it < ntl; it += 2) {
            const int s1_ = slot == 2 ? 0 : slot + 1, s2_ = s1_ == 2 ? 0 : s1_ + 1;
            if (it + 2 < ntl) RPA_GLOAD(kc0 + it + 2, kreg0, vreg0); else if (has_next) RPA_GLOADX(bn, hn, kc0n, kreg0, vreg0);
            tile(kc0 + it, lds + slot * RBUF);
            RPA_LWRITE(lds + s1_ * RBUF, kreg1, vreg1);
            __syncthreads();
            if (it + 3 < ntl) RPA_GLOAD(kc0 + it + 3, kreg1, vreg1);
            else if (has_next) { RPA_GLOADX(bn, hn, kc0n + 1, kreg1, vreg1);
                const bf16_t* qp = Q + ((long)bn * S_ + (grpn * 4 + (wid >> 1)) * 64 + qi) * 1024 + hn * 64 + g * 8;
#pragma unroll
                for (int s = 0; s < 4; ++s) qn[s] = *(const bf16x8*)(qp + 16 * s); }
            tile(kc0 + it + 1, lds + s1_ * RBUF);
            if (it + 2 < ntl) RPA_LWRITE(lds + s2_ * RBUF, kreg0, vreg0);
            __syncthreads();
            slot = s2_;
        }
        const float ltot = xh_sum(lsum), inv = 1.f / ltot;
        bf16_t* yp = Y + tok * 1024 + h * 64 + 4 * g;
#pragma unroll
        for (int dvt = 0; dvt < 2; ++dvt)
#pragma unroll
            for (int a = 0; a < 4; ++a) {
                u32x2 w = {pk2(o[dvt][4 * a] * inv, o[dvt][4 * a + 1] * inv), pk2(o[dvt][4 * a + 2] * inv, o[dvt][4 * a + 3] * inv)};
                *(u32x2*)(yp + dvt * 32 + a * 8) = w;
            }
        pre = has_next;
    }
#undef RPA_GLOADX
}

DI void phase_gla_prep(const Params& p, int wv, int j) {
    LAS float* gl = (LAS float*)smem;
    LAS float* part = gl + 1024;
    bf16_t* Pb = (bf16_t*)(wsptr(p) + OFF_P);
    bf16_t* Q = Pb + GP_Q / 2; bf16_t* K = Pb + GP_K / 2; bf16_t* KT = Pb + GP_KT / 2;
    const float* GL = (const float*)(wsptr(p) + OFF_P + GP_GL);
    float* decay = (float*)(wsptr(p) + OFF_DECAY);
    const float* wg = inptr(p, 2) + (long)j * 16 * 512; const float* bg = inptr(p, 3) + (long)j * 512;
    const int tid_ = phase_tid(wv); const int tid = tid_, d0 = (tid & 63) * 2, tq = tid >> 6;
    f32x4 ngl = {0.f, 0.f, 0.f, 0.f}; f32x2 nw[16]; f32x2 nbg = {0.f, 0.f}; unsigned nqw[8], nkw[8];
#define GP_LOAD(uu) do { const int h_ = (uu) & 3, bc_ = (uu) >> 2, b_ = bc_ >> 8, c_ = bc_ & 255; const long t0_ = (long)b_ * S_ + c_ * 64; \
    if (tid < 256) ngl = *(const f32x4*)(GL + t0_ * 16 + tid * 4); \
    _Pragma("unroll") for (int r = 0; r < 16; ++r) nw[r] = *(const f32x2*)(wg + r * 512 + h_ * 128 + d0); \
    nbg = *(const f32x2*)(bg + h_ * 128 + d0); \
    _Pragma("unroll") for (int i = 0; i < 8; ++i) { const long idx_ = (t0_ + tq * 8 + i) * 512 + h_ * 128 + d0; nqw[i] = *(const unsigned*)(Q + idx_); nkw[i] = *(const unsigned*)(K + idx_); } } while (0)
    if ((int)blockIdx.x < 2048) GP_LOAD(blockIdx.x);
    for (int u = blockIdx.x; u < 2048; u += gridDim.x) {
        const int h = u & 3, bc = u >> 2, b = bc >> 8, c = bc & 255;
        const long tok0 = (long)b * S_ + c * 64;
        if (tid < 256) *(LAS f32x4*)(gl + tid * 4) = ngl;
        f32x2 w[16]; unsigned qw8[8], kw8[8];
#pragma unroll
        for (int r = 0; r < 16; ++r) w[r] = nw[r];
#pragma unroll
        for (int i = 0; i < 8; ++i) { qw8[i] = nqw[i]; kw8[i] = nkw[i]; }
        const f32x2 bgv = nbg;
        __syncthreads();
        f32x2 la[8]; f32x2 run = {0.f, 0.f};
#pragma unroll
        for (int i = 0; i < 8; ++i) {
            const int t = tq * 8 + i; f32x2 lg = bgv;
#pragma unroll
            for (int r4 = 0; r4 < 4; ++r4) { const f32x4 gq = *(const LAS f32x4*)(gl + t * 16 + 4 * r4);
                lg += w[4 * r4] * gq[0] + w[4 * r4 + 1] * gq[1] + w[4 * r4 + 2] * gq[2] + w[4 * r4 + 3] * gq[3]; }
            f32x2 ls;
            ls[0] = fminf(lg[0], 0.f) - __logf(1.f + __expf(-fabsf(lg[0])));
            ls[1] = fminf(lg[1], 0.f) - __logf(1.f + __expf(-fabsf(lg[1])));
            run += ls * (1.f / 16.f); la[i] = run;
        }
        *(LAS f32x2*)(part + tq * 128 + d0) = run;
        __syncthreads();
        if (u + (int)gridDim.x < 2048) GP_LOAD(u + gridDim.x);
        f32x2 off = {0.f, 0.f}, tot = {0.f, 0.f};
#pragma unroll
        for (int k = 0; k < 8; ++k) { const f32x2 v = *(const LAS f32x2*)(part + k * 128 + d0); tot += v; if (k < tq) off += v; }
        unsigned kt0[4], kt1[4];
        float kp0 = 0.f, kp1 = 0.f;
#pragma unroll
        for (int i = 0; i < 8; ++i) {
            const int t = tq * 8 + i; const f32x2 cum = la[i] + off;
            const long idx = (tok0 + t) * 512 + h * 128 + d0;
            const unsigned qw = qw8[i], kw = kw8[i];
            const float q0 = bflo(qw) * 0.08838834764831845f * __expf(cum[0]), q1 = bfhi(qw) * 0.08838834764831845f * __expf(cum[1]);
            const float k0 = bflo(kw) * __expf(-cum[0]), k1 = bfhi(kw) * __expf(-cum[1]);
            *(unsigned*)(Q + idx) = pk2(q0, q1); *(unsigned*)(K + idx) = pk2(k0, k1);
            if (i & 1) { kt0[i >> 1] = pk2(kp0, k0); kt1[i >> 1] = pk2(kp1, k1); } else { kp0 = k0; kp1 = k1; }
        }
        { bf16_t* ktp = KT + ((long)(b * 512 + h * 128 + d0)) * S_ + c * 64 + tq * 8;
          *(u32x4*)ktp = (u32x4){kt0[0], kt0[1], kt0[2], kt0[3]}; *(u32x4*)(ktp + S_) = (u32x4){kt1[0], kt1[1], kt1[2], kt1[3]}; }
        if (tq == 7) *(f32x2*)(decay + ((long)(b * NCH + c)) * 512 + h * 128 + d0) = (f32x2){__expf(tot[0]), __expf(tot[1])};
        __syncthreads();
    }
#undef GP_LOAD
}

constexpr int GQ_STR = 264, GK_STR = 144, GQ_BYTES = 64 * GQ_STR, GK_BYTES = 128 * GK_STR, GBUF = GQ_BYTES + GK_BYTES + 512;
constexpr int NSEG = 32, SEGC = NCH / NSEG;
constexpr size_t OFF_X = OFF_HB, OFF_DS = OFF_HB + 40 * MiB;
template <bool WITH_O>
DI void phase_gla_scan(const Params& p, int wv) {
    LAS unsigned char* lds = (LAS unsigned char*)smem;
    const bf16_t* Pb = (const bf16_t*)(wsptr(p) + OFF_P);
    const bf16_t* Q = Pb + GP_Q / 2; const bf16_t* KT = Pb + GP_KT / 2; const bf16_t* VT = Pb + GP_VT / 2;
    const float* decay = (const float*)(wsptr(p) + OFF_DECAY);
    float* X = (float*)(wsptr(p) + OFF_X); float* DS = (float*)(wsptr(p) + OFF_DS);
    bf16_t* Y = (bf16_t*)(wsptr(p) + OFF_Y);
    const int tid_ = phase_tid(wv); const int tid = tid_, wid = __builtin_amdgcn_readfirstlane(tid >> 6), lane = tid & 63, l32 = lane & 31, g = lane >> 5;
    for (int u = blockIdx.x; u < 8 * NSEG; u += gridDim.x) {
        const int bh = u / NSEG, seg = u % NSEG, b = bh >> 2, h = bh & 3;
        const int c0 = seg * SEGC;
        const int dvc = h * 256 + wid * 32 + l32;
        f32x16 St[4]; bf16x8 Sb[8];
        float* xw = X + ((long)(bh * NSEG + seg)) * 32768 + wid * 4096 + lane;
        if (WITH_O) {
#pragma unroll
            for (int t = 0; t < 4; ++t) {
#pragma unroll
                for (int i = 0; i < 16; ++i) St[t][i] = xw[(t * 16 + i) * 64];
                Sb[2 * t] = pack_lo(St[t]); Sb[2 * t + 1] = pack_hi(St[t]);
            }
        } else {
            for (int t = 0; t < 4; ++t) St[t] = zero16();
            for (int s = 0; s < 8; ++s) Sb[s] = (bf16x8){0, 0, 0, 0, 0, 0, 0, 0};
            if (tid < 128) {
                float dp = 1.f;
                for (int c = 0; c < SEGC; ++c) dp *= decay[((long)(b * NCH + c0 + c)) * 512 + h * 128 + tid];
                DS[(bh * NSEG + seg) * 128 + tid] = dp;
            }
        }
        u32x4 qreg[2], kreg[2]; f32x4 dreg; bf16x8 vcur[4], vnext[4];
        const unsigned gq_off = (unsigned)((tid >> 4) * 512 + (tid & 15) * 8) * 2u, gk_off = (unsigned)((tid >> 3) * S_ + (tid & 7) * 8) * 2u, gv_off = (unsigned)(l32 * S_ + 8 * g) * 2u;
#define GLA_GLOAD(c) do { const long t0 = (long)b * S_ + (long)(c) * 64; \
    const char* qb_ = (const char*)(Q + t0 * 512 + h * 128); const char* ktb = (const char*)(KT + ((long)(b * 512 + h * 128)) * S_ + (long)(c) * 64); \
    const char* vtb = (const char*)(VT + ((long)(b * 1024 + h * 256 + wid * 32)) * S_ + (long)(c) * 64); \
    if (WITH_O) { qreg[0] = *(const u32x4*)(qb_ + gq_off); qreg[1] = *(const u32x4*)(qb_ + 32768 + gq_off); } \
    kreg[0] = *(const u32x4*)(ktb + gk_off); kreg[1] = *(const u32x4*)(ktb + 64L * S_ * 2 + gk_off); \
    if (tid < 32) dreg = *(const f32x4*)(decay + ((long)(b * NCH + (c))) * 512 + h * 128 + tid * 4); \
    _Pragma("unroll") for (int ks = 0; ks < 4; ++ks) vnext[ks] = *(const bf16x8*)(vtb + gv_off + ks * 32); } while (0)
#define GLA_LWRITE(bufp) do { LAS unsigned char* _bp = (bufp); \
    if (WITH_O) { { const int id = tid; LAS unsigned char* a = _bp + (id >> 4) * GQ_STR + (id & 15) * 16; \
      *(LAS u32x2*)a = (u32x2){qreg[0][0], qreg[0][1]}; *(LAS u32x2*)(a + 8) = (u32x2){qreg[0][2], qreg[0][3]}; } \
    { const int id = tid + 512; LAS unsigned char* a = _bp + (id >> 4) * GQ_STR + (id & 15) * 16; \
      *(LAS u32x2*)a = (u32x2){qreg[1][0], qreg[1][1]}; *(LAS u32x2*)(a + 8) = (u32x2){qreg[1][2], qreg[1][3]}; } } \
    { const int id = tid; *(LAS u32x4*)(_bp + GQ_BYTES + (id >> 3) * GK_STR + (id & 7) * 16) = kreg[0]; } \
    { const int id = tid + 512; *(LAS u32x4*)(_bp + GQ_BYTES + (id >> 3) * GK_STR + (id & 7) * 16) = kreg[1]; } \
    if (tid < 32) *(LAS f32x4*)(_bp + GQ_BYTES + GK_BYTES + tid * 16) = dreg; } while (0)
        GLA_GLOAD(c0); GLA_LWRITE(lds);
#pragma unroll
        for (int ks = 0; ks < 4; ++ks) vcur[ks] = vnext[ks];
        __syncthreads();
        for (int ci = 0; ci < SEGC; ++ci) {
            const int c = c0 + ci;
            LAS unsigned char* buf = lds + (ci & 1) * GBUF;
            if (ci + 1 < SEGC) GLA_GLOAD(c + 1);
            if (WITH_O) {
#pragma unroll
                for (int qt = 0; qt < 2; ++qt) {
                    f32x16 acc = zero16();
                    LAS unsigned char* qb = buf + (32 * qt + l32) * GQ_STR + g * 8;
#pragma unroll
                    for (int s = 0; s < 8; ++s) {
                        const u32x2 lo = *(const LAS u32x2*)(qb + s * 32), hi = *(const LAS u32x2*)(qb + s * 32 + 16);
                        u32x4 a4 = {lo[0], lo[1], hi[0], hi[1]};
                        acc = MFMA32(__builtin_bit_cast(bf16x8, a4), Sb[s], acc);
                    }
                    bf16_t* yp = Y + ((long)b * S_ + c * 64 + 32 * qt + 4 * g) * 1024 + dvc;
#pragma unroll
                    for (int i = 0; i < 16; ++i) yp[(long)(8 * (i >> 2) + (i & 3)) * 1024] = f2bf(acc[i]);
                }
            }
#pragma unroll
            for (int t = 0; t < 4; ++t) {
                LAS unsigned char* kb = buf + GQ_BYTES + (32 * t + l32) * GK_STR + g * 16;
#pragma unroll
                for (int ks = 0; ks < 4; ++ks) {
                    const bf16x8 a = *(const LAS bf16x8*)(kb + ks * 32);
                    St[t] = MFMA32(a, vcur[ks], St[t]);
                }
                LAS unsigned char* db = buf + GQ_BYTES + GK_BYTES + (32 * t + 4 * g) * 4;
#pragma unroll
                for (int a = 0; a < 4; ++a) {
                    const f32x4 d4 = *(const LAS f32x4*)(db + a * 32);
#pragma unroll
                    for (int jj = 0; jj < 4; ++jj) St[t][4 * a + jj] *= d4[jj];
                }
                if (WITH_O) { Sb[2 * t] = pack_lo(St[t]); Sb[2 * t + 1] = pack_hi(St[t]); }
            }
            if (ci + 1 < SEGC) { GLA_LWRITE(lds + ((ci + 1) & 1) * GBUF);
#pragma unroll
                for (int ks = 0; ks < 4; ++ks) vcur[ks] = vnext[ks]; }
            __syncthreads();
        }
        if (!WITH_O) {
#pragma unroll
            for (int t = 0; t < 4; ++t)
#pragma unroll
                for (int i = 0; i < 16; ++i) xw[(t * 16 + i) * 64] = St[t][i];
        }
    }
#undef GLA_GLOAD
#undef GLA_LWRITE
}
DI void phase_gla_combine(const Params& p, int wv) {
    float* X = (float*)(wsptr(p) + OFF_X); const float* DS = (const float*)(wsptr(p) + OFF_DS);
    const int tid_ = phase_tid(wv); const int tid = tid_;
    for (int idx = blockIdx.x * NTHR + tid; idx < 8 * 32768; idx += gridDim.x * NTHR) {
        const int bh = idx >> 15, e = idx & 32767;
        const int lane = e & 63, ti = (e >> 6) & 63, t = ti >> 4, i = ti & 15;
        const int dk = 32 * t + 8 * (i >> 2) + 4 * (lane >> 5) + (i & 3);
        float r = 0.f;
        float* xp = X + (long)bh * NSEG * 32768 + e;
        const float* dp = DS + bh * NSEG * 128 + dk;
#pragma unroll 4
        for (int seg = 0; seg < NSEG; ++seg) {
            const float tmp = xp[(long)seg * 32768], D = dp[seg * 128];
            xp[(long)seg * 32768] = r;
            r = r * D + tmp;
        }
    }
}

constexpr int OQ_STR = 272, OV_STR = 144, OQ_BYTES = 64 * OQ_STR, OV_BYTES = 256 * OV_STR, O_XS_OFF = 2 * OQ_BYTES + OV_BYTES;
DI void phase_gla_out(const Params& p, int wv, int j) {
    LAS unsigned char* lds = (LAS unsigned char*)smem;
    LAS float* OL = (LAS float*)(lds + O_XS_OFF);
    const bf16_t* Pb = (const bf16_t*)(wsptr(p) + OFF_P);
    const bf16_t* Q = Pb + GP_Q / 2; const bf16_t* K = Pb + GP_K / 2; const bf16_t* VT = Pb + GP_VT / 2; const bf16_t* R = Pb + GP_R / 2;
    bf16_t* Y = (bf16_t*)(wsptr(p) + OFF_Y);
    const float* ng = inptr(p, 4) + (long)j * 1024;
    const int tid_ = phase_tid(wv); const int tid = tid_, wid = __builtin_amdgcn_readfirstlane(tid >> 6), lane = tid & 63, l32 = lane & 31, g = lane >> 5;
    const int qt = wid & 1, dq = wid >> 1;
    const int qi = 32 * qt + l32;
    const int krow = (l32 & 19) | ((l32 & 4) << 1) | ((l32 & 8) >> 1);
    u32x4 qreg[2], kreg[2], vreg[4];
    const unsigned qk_off = (unsigned)((tid >> 4) * 512 + (tid & 15) * 8) * 2u, v_off = (unsigned)((tid >> 3) * S_ + (tid & 7) * 8) * 2u;
#define GO_GLOAD(uu) do { const int h_ = (uu) & 3, bc_ = (uu) >> 2, b_ = bc_ >> 8, c_ = bc_ & 255; const long t0_ = (long)b_ * S_ + c_ * 64; \
    const char* qb_ = (const char*)(Q + t0_ * 512 + h_ * 128); const char* kb_ = (const char*)(K + t0_ * 512 + h_ * 128); \
    const char* vb_ = (const char*)(VT + ((long)(b_ * 1024 + h_ * 256)) * S_ + c_ * 64); \
    qreg[0] = *(const u32x4*)(qb_ + qk_off); qreg[1] = *(const u32x4*)(qb_ + 32768 + qk_off); \
    kreg[0] = *(const u32x4*)(kb_ + qk_off); kreg[1] = *(const u32x4*)(kb_ + 32768 + qk_off); \
    _Pragma("unroll") for (int i_ = 0; i_ < 4; ++i_) vreg[i_] = *(const u32x4*)(vb_ + (size_t)i_ * 64 * S_ * 2 + v_off); } while (0)
#define GO_LWRITE() do { \
    *(LAS u32x4*)(lds + (tid >> 4) * OQ_STR + (tid & 15) * 16) = qreg[0]; *(LAS u32x4*)(lds + (32 + (tid >> 4)) * OQ_STR + (tid & 15) * 16) = qreg[1]; \
    *(LAS u32x4*)(lds + OQ_BYTES + (tid >> 4) * OQ_STR + (tid & 15) * 16) = kreg[0]; *(LAS u32x4*)(lds + OQ_BYTES + (32 + (tid >> 4)) * OQ_STR + (tid & 15) * 16) = kreg[1]; \
    _Pragma("unroll") for (int i_ = 0; i_ < 4; ++i_) *(LAS u32x4*)(lds + 2 * OQ_BYTES + (i_ * 64 + (tid >> 3)) * OV_STR + (tid & 7) * 16) = vreg[i_]; } while (0)
    if ((int)blockIdx.x < 2048) { GO_GLOAD(blockIdx.x); GO_LWRITE(); }
    __syncthreads();
    for (int u = blockIdx.x; u < 2048; u += gridDim.x) {
        const int h = u & 3, bc = u >> 2, b = bc >> 8, c = bc & 255;
        const long tok0 = (long)b * S_ + c * 64;
        const bool has_next = u + (int)gridDim.x < 2048;
        if (has_next) GO_GLOAD(u + gridDim.x);
        bf16x8 qf[8];
        { LAS unsigned char* qp = lds + qi * OQ_STR + g * 16;
#pragma unroll
          for (int s = 0; s < 8; ++s) qf[s] = *(const LAS bf16x8*)(qp + 32 * s); }
        f32x16 sT[2] = {zero16(), zero16()};
#pragma unroll
        for (int hh = 0; hh < 2; ++hh) {
            if (hh <= qt) {
                LAS unsigned char* kp = lds + OQ_BYTES + (32 * hh + krow) * OQ_STR + g * 16;
#pragma unroll
                for (int s = 0; s < 8; ++s) { const bf16x8 a = *(const LAS bf16x8*)(kp + 32 * s); sT[hh] = MFMA32(a, qf[s], sT[hh]); }
#pragma unroll
                for (int i = 0; i < 16; ++i) { const int key = 32 * hh + 16 * (i >> 3) + 8 * g + (i & 7); if (key > qi) sT[hh][i] = 0.f; }
            }
        }
        bf16x8 pb[4] = {pack_lo(sT[0]), pack_hi(sT[0]), pack_lo(sT[1]), pack_hi(sT[1])};
        f32x16 o[2] = {zero16(), zero16()};
#pragma unroll
        for (int dvt = 0; dvt < 2; ++dvt) {
            LAS unsigned char* vp = lds + 2 * OQ_BYTES + (dq * 64 + dvt * 32 + l32) * OV_STR + g * 16;
#pragma unroll
            for (int ss = 0; ss < 4; ++ss) {
                const bf16x8 a8 = *(const LAS bf16x8*)(vp + 32 * ss);
                o[dvt] = MFMA32(a8, pb[ss], o[dvt]);
            }
        }
        { LAS float* op = OL + qi * 260 + dq * 64 + 4 * g;
#pragma unroll
          for (int dvt = 0; dvt < 2; ++dvt)
#pragma unroll
              for (int a = 0; a < 4; ++a) *(LAS f32x4*)(op + dvt * 32 + a * 8) = (f32x4){o[dvt][4 * a], o[dvt][4 * a + 1], o[dvt][4 * a + 2], o[dvt][4 * a + 3]}; }
        __syncthreads();
        if (has_next) GO_LWRITE();
#pragma unroll
        for (int k = 0; k < 4; ++k) {
            const int cidx = tid + 512 * k, row = cidx >> 5, col = (cidx & 31) * 8;
            const f32x4 oa = *(const LAS f32x4*)(OL + row * 260 + col), ob = *(const LAS f32x4*)(OL + row * 260 + col + 4);
            bf16_t* yrow = Y + (tok0 + row) * 1024 + h * 256 + col;
            const u32x4 yi = *(const u32x4*)yrow;
            float v[8] = {oa[0] + bflo(yi[0]), oa[1] + bfhi(yi[0]), oa[2] + bflo(yi[1]), oa[3] + bfhi(yi[1]),
                          ob[0] + bflo(yi[2]), ob[1] + bfhi(yi[2]), ob[2] + bflo(yi[3]), ob[3] + bfhi(yi[3])};
            float sum = 0.f, ssq = 0.f;
#pragma unroll
            for (int e = 0; e < 8; ++e) { sum += v[e]; ssq += v[e] * v[e]; }
#pragma unroll
            for (int sh = 1; sh < 32; sh <<= 1) { sum += shx(sum, sh, lane); ssq += shx(ssq, sh, lane); }
            const float mu = sum * (1.f / 256.f), var = fmaxf(ssq * (1.f / 256.f) - mu * mu, 0.f), rstd = 1.0f / sqrtf(var + 1e-5f);
            const u32x4 ri = *(const u32x4*)(R + (tok0 + row) * 1024 + h * 256 + col);
            const f32x4 ga = *(const f32x4*)(ng + h * 256 + col), gb = *(const f32x4*)(ng + h * 256 + col + 4);
            const float rv[8] = {bflo(ri[0]), bfhi(ri[0]), bflo(ri[1]), bfhi(ri[1]), bflo(ri[2]), bfhi(ri[2]), bflo(ri[3]), bfhi(ri[3])};
            float yv[8];
#pragma unroll
            for (int e = 0; e < 8; ++e) { const float r = rv[e], gg = e < 4 ? ga[e & 3] : gb[e & 3]; yv[e] = r * __builtin_amdgcn_rcpf(1.f + __expf(-r)) * ((v[e] - mu) * rstd * gg); }
            *(u32x4*)yrow = (u32x4){pk2(yv[0], yv[1]), pk2(yv[2], yv[3]), pk2(yv[4], yv[5]), pk2(yv[6], yv[7])};
        }
        __syncthreads();
    }
#undef GO_GLOAD
#undef GO_LWRITE
}

#define XB_TMO      128
#define XB_XCNT(j)  (256  + 64 * (j))
#define XB_XSUB(j)  (1280 + 64 * (j))
#define XB_XGEN(j)  (2304 + 64 * (j))
#define XB_TOP      3328
#define XB_TOPGEN   3392
#define XCD_BAR_WORDS 3456
#define XB_SPIN_CAP (1u << 22)
DI unsigned xb_ld(unsigned* p) { return __hip_atomic_load(p, __ATOMIC_RELAXED, __HIP_MEMORY_SCOPE_AGENT); }
DI unsigned xb_add(unsigned* p, unsigned v) { return __hip_atomic_fetch_add(p, v, __ATOMIC_RELAXED, __HIP_MEMORY_SCOPE_AGENT); }
DI unsigned xb_xcc_id() { return (unsigned)__builtin_amdgcn_s_getreg((3 << 11) | 20) & 0xFu; }
#define XB_SPIN(cond, bar) do { unsigned _sp = 0; while (cond) { __builtin_amdgcn_s_sleep(1); \
    if ((++_sp & 255u) == 0u) { if (xb_ld(&(bar)[XB_TMO])) break; if (_sp > XB_SPIN_CAP) { atomicAdd(&(bar)[XB_TMO], 1u); break; } } } } while (0)
DI void xcd_barrier_complete(unsigned* bar, unsigned x, unsigned& nloc, unsigned& nx) {
    const unsigned G = gridDim.x;
    unsigned sum, cnt, mine, sp = 0u;
    for (;;) {
        sum = 0u; cnt = 0u; mine = 0u;
#pragma unroll
        for (unsigned j = 0; j < 16; ++j) { const unsigned c = xb_ld(&bar[XB_XCNT(j)]); sum += c; cnt += (c > 0u) ? 1u : 0u; mine = (j == x) ? c : mine; }
        if (sum == G) break;
        __builtin_amdgcn_s_sleep(1);
        if ((++sp & 255u) == 0u) { if (xb_ld(&bar[XB_TMO])) break; if (sp > XB_SPIN_CAP) { atomicAdd(&bar[XB_TMO], 1u); break; } }
    }
    nloc = mine > 0u ? mine : 1u; nx = cnt > 0u ? cnt : 1u;
}
DI void grid_bar(unsigned* bar) {
    volatile LAS unsigned* st = (volatile LAS unsigned*)((LAS unsigned char*)smem + LDS_BYTES);
    asm volatile("s_waitcnt vmcnt(0)" ::: "memory");
    __syncthreads();
    if (threadIdx.x == 0) {
        __builtin_amdgcn_s_waitcnt(0);
        const unsigned x = xb_xcc_id();
        unsigned nloc = st[0], nx = st[1];
        if (nloc == 0u) { xcd_barrier_complete(bar, x, nloc, nx); st[0] = nloc; st[1] = nx; }
        const unsigned old = xb_add(&bar[XB_XSUB(x)], 1u);
        const unsigned gen = old / nloc;
        if (old + 1u == (gen + 1u) * nloc) {
            __builtin_amdgcn_fence(__ATOMIC_RELEASE, "agent");
            asm volatile("s_waitcnt vmcnt(0)" ::: "memory");
            const unsigned og = xb_add(&bar[XB_TOP], 1u);
            const unsigned tg = og / nx;
            if (og + 1u == (tg + 1u) * nx) xb_add(&bar[XB_TOPGEN], 1u);
            else XB_SPIN(xb_ld(&bar[XB_TOPGEN]) == tg, bar);
            __builtin_amdgcn_fence(__ATOMIC_ACQUIRE, "agent");
            xb_add(&bar[XB_XGEN(x)], 1u);
            asm volatile("s_waitcnt vmcnt(0)" ::: "memory");
        } else {
            XB_SPIN(xb_ld(&bar[XB_XGEN(x)]) == gen, bar);
            __builtin_amdgcn_fence(__ATOMIC_ACQUIRE, "agent");
            asm volatile("s_waitcnt vmcnt(0)" ::: "memory");
        }
    }
    __syncthreads();
}
#ifndef PHM
#define PHM 0xFFFF
#endif
#define PH(k) ((PHM >> (k)) & 1)
__global__ void __launch_bounds__(NTHR) fwd_kernel(Params p) {
    cg::grid_group grid = cg::this_grid();
    const int wv = __builtin_amdgcn_readfirstlane((int)threadIdx.x >> 6);
    unsigned* bar = (unsigned*)wsptr(p);
    { volatile LAS unsigned* st = (volatile LAS unsigned*)((LAS unsigned char*)smem + LDS_BYTES);
      if (threadIdx.x == 0) { st[0] = 0u; st[1] = 0u; (void)xb_add(&bar[XB_XCNT(xb_xcc_id())], 1u); } __syncthreads(); }
#define W ((const bf16_t*)(wsptr(p) + OFF_W))
#define HB ((bf16_t*)(wsptr(p) + OFF_HB))
#define Y ((bf16_t*)(wsptr(p) + OFF_Y))
#define Pb ((bf16_t*)(wsptr(p) + OFF_P))
#define H (outptr(p))
#define STATP ((float*)(wsptr(p) + OFF_STAT))
#define LNG(i) (inptr(p, 17) + (long)(i) * 1024)
#define LNB(i) (inptr(p, 18) + (long)(i) * 1024)
#define LNXP(i) ((unsigned long long*)(wsptr(p) + OFF_LNX) + (long)(i) * 131072)
#define LNCP(i) ((unsigned*)(wsptr(p) + OFF_LNC) + (i) * 2048)

    if (PH(0)) phase_convert(p, wv);
    if (p.conv_tiles < 0) grid.sync();
    grid_bar((unsigned*)wsptr(p));
#pragma unroll 1
    for (int layer = 0; layer < 4; ++layer) {
        const int mix = layer % 3, j = layer / 3;
        if (mix == 0) {
            if (PH(1)) { EpiGlaIn e{Pb, (float*)(wsptr(p) + OFF_P + GP_GL)}; gemm_phase(wv, HB, 1024, W + p.w_gla_in[j], 1024, T_, 3328, 1024, e); }
            grid_bar((unsigned*)wsptr(p));
            if (PH(2)) phase_gla_prep(p, wv, j);
            grid_bar((unsigned*)wsptr(p));
            if (PH(3)) phase_gla_scan<false>(p, wv);
            grid_bar((unsigned*)wsptr(p));
            if (PH(3)) phase_gla_combine(p, wv);
            grid_bar((unsigned*)wsptr(p));
            if (PH(3)) phase_gla_scan<true>(p, wv);
            grid_bar((unsigned*)wsptr(p));
            if (PH(4)) phase_gla_out(p, wv, j);
            grid_bar((unsigned*)wsptr(p));
            if (PH(5)) { EpiResLN e{(layer == 0) ? inptr(p, 0) : H, H, HB, LNG(layer * 2), LNB(layer * 2), LNXP(layer * 2), LNCP(layer * 2)}; gemm_phase(wv, Y, 1024, W + p.w_gla_out[j], 1024, T_, 1024, 1024, e); }
        } else if (mix == 1) {
            if (PH(6)) { EpiRpaIn e{Pb, 0.125f * LOG2E}; gemm_phase(wv, HB, 1024, W + p.w_rpa_in, 1024, T_, 3072, 1024, e); }
            grid_bar((unsigned*)wsptr(p));
            if (PH(7)) phase_rpa_attn(p, wv);
            grid_bar((unsigned*)wsptr(p));
            if (PH(5)) { EpiResLN e{(layer == 0) ? inptr(p, 0) : H, H, HB, LNG(layer * 2), LNB(layer * 2), LNXP(layer * 2), LNCP(layer * 2)}; gemm_phase(wv, Y, 1024, W + p.w_rpa_out, 1024, T_, 1024, 1024, e); }
        } else {
            if (PH(8)) { EpiPlain e{Y, 768, 1.f}; gemm_phase(wv, HB, 1024, W + p.w_mla_in, 1024, T_, 768, 1024, e); }
            grid_bar((unsigned*)wsptr(p));
            if (PH(9)) phase_mla_norm(p, wv);
            grid_bar((unsigned*)wsptr(p));
            if (PH(8)) { EpiPlain e{Pb + MP_Q / 2, 1536, 0.07216878364870322f * LOG2E}; gemm_phase(wv, Y, 768, W + p.w_mla_uq, 384, T_, 1536, 384, e); }
            if (PH(10)) { EpiMlaKv e{Pb + MP_KN / 2, Pb + MP_VT / 2}; gemm_phase(wv, Y + 384, 768, W + p.w_mla_ukv, 256, T_, 2048, 256, e); }
            grid_bar((unsigned*)wsptr(p));
            if (PH(11)) phase_mla_attn(p, wv);
            grid_bar((unsigned*)wsptr(p));
            if (PH(5)) { EpiResLN e{(layer == 0) ? inptr(p, 0) : H, H, HB, LNG(layer * 2), LNB(layer * 2), LNXP(layer * 2), LNCP(layer * 2)}; gemm_phase(wv, Y, 1024, W + p.w_mla_out, 1024, T_, 1024, 1024, e); }
        }
        grid_bar((unsigned*)wsptr(p));
        if (PH(13)) { EpiSwiglu e{Pb}; gemm_phase(wv, HB, 1024, W + p.w_ffn_in[layer], 1024, T_, 2 * FFH, 1024, e); }
        grid_bar((unsigned*)wsptr(p));
        if (PH(5)) { EpiResLN e{H, H, HB, LNG(layer * 2 + 1), LNB(layer * 2 + 1), LNXP(layer * 2 + 1), LNCP(layer * 2 + 1)}; gemm_phase(wv, Pb, FFH, W + p.w_ffn_out[layer], FFH, T_, 1024, FFH, e); }
        grid_bar((unsigned*)wsptr(p));
    }
}

#undef W
#undef HB
#undef Y
#undef Pb
#undef H
#undef STATP
#undef LNG
#undef LNB
#undef LNXP
#undef LNCP
extern "C" void kernel_launch(void* const* d_in, const int* in_sizes, int n_in, void* d_out, int out_size, void* d_ws, size_t ws_size, hipStream_t stream) {
    static int grid_blocks = 0;
    if (!grid_blocks) {
        int dev = 0, cus = 0, per_cu = 0;
        hipGetDevice(&dev);
        hipDeviceGetAttribute(&cus, hipDeviceAttributeMultiprocessorCount, dev);
        hipFuncSetAttribute((const void*)fwd_kernel, hipFuncAttributeMaxDynamicSharedMemorySize, LDS_BYTES + 64);
        hipOccupancyMaxActiveBlocksPerMultiprocessor(&per_cu, (const void*)fwd_kernel, NTHR, LDS_BYTES + 64);
        if (per_cu < 1) per_cu = 1;
        grid_blocks = cus * per_cu;
        if (ws_size < 472 * MiB) fprintf(stderr, "kernel_launch: workspace too small: %zu\n", ws_size);
    }
    Params p; memset(&p, 0, sizeof(p));
    for (int i = 0; i < 19; ++i) p.in[i] = (const float*)d_in[i];
    p.out = (float*)d_out; p.ws = (unsigned char*)d_ws;
    long woff = 0; int nd = 0, tiles = 0;
    auto add = [&](int idx, long src_off, int K, int Nsrc, int Npad, int perm) -> long {
        ConvDesc& c = p.cd[nd++]; c.in_idx = idx; c.K = K; c.Nsrc = Nsrc; c.Npad = Npad; c.perm = perm; c.tile0 = tiles; c.src_off = src_off; c.dst_off = woff;
        tiles += (K / 64) * (Npad / 64); const long o = woff; woff += (long)K * Npad; return o;
    };
    for (int j = 0; j < 2; ++j) { p.w_gla_in[j] = add(1, (long)j * 1024 * 3088, 1024, 3088, 3328, 0); p.w_gla_out[j] = add(5, (long)j * 1024 * 1024, 1024, 1024, 1024, 0); }
    p.w_rpa_in = add(6, 0, 1024, 3072, 3072, 0); p.w_rpa_out = add(8, 0, 1024, 1024, 1024, 0);
    p.w_mla_in = add(9, 0, 1024, 704, 768, 0); p.w_mla_uq = add(12, 0, 384, 1536, 1536, 0); p.w_mla_ukv = add(13, 0, 256, 2048, 2048, 0); p.w_mla_out = add(14, 0, 1024, 1024, 1024, 0);
    for (int l = 0; l < 4; ++l) { p.w_ffn_in[l] = add(15, (long)l * 1024 * 5632, 1024, 5632, 5632, 1); p.w_ffn_out[l] = add(16, (long)l * FFH * 1024, FFH, 1024, 1024, 0); }
    p.ncd = nd; p.conv_tiles = tiles;
    hipMemsetAsync(d_ws, 0, 131072, stream);
    void* args[] = {&p};
    hipError_t e = hipLaunchCooperativeKernel((const void*)fwd_kernel, dim3(grid_blocks), dim3(NTHR), args, LDS_BYTES + 64, stream);
    if (e != hipSuccess) fprintf(stderr, "cooperative launch failed: %s (grid %d)\n", hipGetErrorString(e), grid_blocks);
}
```

```cpp
#include <hip/hip_runtime.h>
#include <hip/hip_cooperative_groups.h>
#include <cstdint>
#include <cstdio>
#include <cstring>
namespace cg = cooperative_groups;

#define LAS __attribute__((address_space(3)))
#define DI __device__ __forceinline__
typedef unsigned short bf16_t;
typedef short bf16x8 __attribute__((ext_vector_type(8)));
typedef float f32x4 __attribute__((ext_vector_type(4)));
typedef float f32x2 __attribute__((ext_vector_type(2)));
typedef float f32x16 __attribute__((ext_vector_type(16)));
typedef unsigned u32x4 __attribute__((ext_vector_type(4)));
typedef unsigned u32x2 __attribute__((ext_vector_type(2)));
typedef __bf16 bfx2 __attribute__((ext_vector_type(2)));

constexpr int T_ = 32768, S_ = 16384, NCH = 256;
constexpr int FFH = 2816;
constexpr float ALPHA = 1.6817928305074290f;
constexpr float LOG2E = 1.4426950408889634f;
constexpr int NTHR = 512;
constexpr int LDS_BYTES = 155648;

constexpr size_t MiB = 1024 * 1024;
constexpr size_t OFF_COS = 1 * MiB, OFF_SIN = 3 * MiB, OFF_DECAY = 5 * MiB, OFF_STAT = 6 * MiB, OFF_W = 8 * MiB;
constexpr size_t OFF_HB = 106 * MiB, OFF_Y = 170 * MiB, OFF_P = 234 * MiB;
constexpr size_t GP_Q = 0, GP_K = 32 * MiB, GP_KT = 64 * MiB, GP_VT = 96 * MiB, GP_R = 160 * MiB, GP_GL = 224 * MiB;
constexpr size_t RP_Q = 0, RP_K = 64 * MiB, RP_VT = 128 * MiB;
constexpr size_t MP_Q = 0, MP_KN = 96 * MiB, MP_VT = 160 * MiB, MP_KR = 224 * MiB;

struct ConvDesc { int in_idx, K, Nsrc, Npad, perm, tile0; long src_off, dst_off; };
struct Params {
    const float* in[19]; float* out; unsigned char* ws;
    ConvDesc cd[18]; int ncd, conv_tiles;
    long w_gla_in[2], w_gla_out[2], w_rpa_in, w_rpa_out, w_mla_in, w_mla_uq, w_mla_ukv, w_mla_out, w_ffn_in[4], w_ffn_out[4];
};

extern __shared__ __attribute__((aligned(16))) unsigned char smem[];

DI unsigned pk2(float lo, float hi) { f32x2 v = {lo, hi}; bfx2 b = __builtin_convertvector(v, bfx2); return __builtin_bit_cast(unsigned, b); }
DI bf16_t f2bf(float x) { return (bf16_t)(pk2(x, 0.f) & 0xffffu); }
DI float bf2f(unsigned v) { return __uint_as_float(v << 16); }
DI float bflo(unsigned u) { return __uint_as_float(u << 16); }
DI float bfhi(unsigned u) { return __uint_as_float(u & 0xffff0000u); }
DI bf16x8 pack8(float a0, float a1, float a2, float a3, float a4, float a5, float a6, float a7) {
    u32x4 p = {pk2(a0, a1), pk2(a2, a3), pk2(a4, a5), pk2(a6, a7)}; return __builtin_bit_cast(bf16x8, p);
}
#define MFMA32(a, b, c) __builtin_amdgcn_mfma_f32_32x32x16_bf16((a), (b), (c), 0, 0, 0)
DI f32x16 zero16() { f32x16 z; for (int i = 0; i < 16; ++i) z[i] = 0.f; return z; }
DI bf16x8 pack_lo(const f32x16& x) { return pack8(x[0], x[1], x[2], x[3], x[4], x[5], x[6], x[7]); }
DI bf16x8 pack_hi(const f32x16& x) { return pack8(x[8], x[9], x[10], x[11], x[12], x[13], x[14], x[15]); }
DI int phase_tid(int wv) { int z = 0; asm volatile("" : "+s"(wv), "+s"(z)); const int lane = __builtin_amdgcn_mbcnt_hi(~0u, __builtin_amdgcn_mbcnt_lo(~0u, z)); return wv * 64 + lane; }
DI float shx(float v, int m, int lane) { return __int_as_float(__builtin_amdgcn_ds_bpermute((lane ^ m) << 2, __float_as_int(v))); }
DI float xh_max(float v) { const auto r = __builtin_amdgcn_permlane32_swap(__float_as_uint(v), __float_as_uint(v), false, false); return fmaxf(__uint_as_float(r[0]), __uint_as_float(r[1])); }
DI float xh_sum(float v) { const auto r = __builtin_amdgcn_permlane32_swap(__float_as_uint(v), __float_as_uint(v), false, false); return __uint_as_float(r[0]) + __uint_as_float(r[1]); }
DI unsigned char* wsptr(const Params& p) { int z = 0; asm volatile("" : "+s"(z)); return p.ws + z; }
DI float* outptr(const Params& p) { int z = 0; asm volatile("" : "+s"(z)); return p.out + z; }
DI const float* inptr(const Params& p, int i) { asm volatile("" : "+s"(i)); return p.in[i]; }
DI int vcu_of_block() { const int G = gridDim.x, bx = blockIdx.x; return (G % 8 == 0) ? (bx % 8) * (G / 8) + bx / 8 : bx; }

constexpr int BM = 256, BK = 64, HALF = 128, NXCD = 8, WGM = 8, HT = HALF * BK;
DI int lds_byte(int r, int c) { int st = (r >> 4) * 2 + (c >> 5), rr = r & 15, cc = c & 31, ob = rr * 64 + cc * 2; return st * 1024 + (ob ^ (((ob >> 9) & 1) << 5)); }
DI void stage_rc(int b, int& R, int& C) { int st = b / 1024, sb = b % 1024, swz = sb ^ (((sb >> 9) & 1) << 5); R = (st >> 1) * 16 + swz / 64; C = (st & 1) * 32 + (swz % 64) / 2; }

typedef f32x4 AccT[2][2][4][2];

template <class Epi>
DI void gemm_phase(int wv, const bf16_t* __restrict__ A, int lda, const bf16_t* __restrict__ Bt, int ldb, int M, int N, int K, const Epi& epi) {
    LAS unsigned char* lds = (LAS unsigned char*)smem;
    const int tid_ = phase_tid(wv); const int tid = tid_, wid = __builtin_amdgcn_readfirstlane(tid >> 6), lane = tid & 63, wr = wid >> 2, wc = wid & 3, fr = lane & 15, fq = lane >> 4;
    unsigned voffA[2], voffB[2];
#pragma unroll
    for (int i = 0; i < 2; ++i) { int R, C; stage_rc(tid * 16 + i * 8192, R, C); voffA[i] = (unsigned)(R * lda + C) * 2u; voffB[i] = (unsigned)(R * ldb + C) * 2u; }
    const size_t kstep = (size_t)(BK * 2), hstepA = (size_t)HALF * lda * 2, hstepB = (size_t)HALF * ldb * 2;
    const unsigned ldsw = (unsigned)wid * 1024u;
    const int aoff = lds_byte(wr * 64 + fr, fq * 8), boff = lds_byte(wc * 32 + fr, fq * 8);
    constexpr int HTB = HT * 2;
#define SA(b, h) (((b) * 2 + (h)) * HTB)
#define SB(b, h) ((4 + (b) * 2 + (h)) * HTB)
#define STAGE(bufoff, gbase, voff) do { _Pragma("unroll") for (int _i = 0; _i < 2; ++_i) \
    __builtin_amdgcn_global_load_lds((const unsigned*)((const char*)(gbase) + (voff)[_i]), (LAS unsigned*)(lds + (bufoff) + ldsw + _i * 8192), 16, 0, 0); } while (0)
#define LDA(dst, b, h) do { _Pragma("unroll") for (int m = 0; m < 4; ++m) _Pragma("unroll") for (int k = 0; k < 2; ++k) dst[m][k] = *(const LAS bf16x8*)(lds + SA(b, h) + aoff + m * 2048 + k * 1024); } while (0)
#define LDB(dst, b, h) do { _Pragma("unroll") for (int n = 0; n < 2; ++n) _Pragma("unroll") for (int k = 0; k < 2; ++k) dst[n][k] = *(const LAS bf16x8*)(lds + SB(b, h) + boff + n * 2048 + k * 1024); } while (0)
#define MMA(ai, bj, At_, Bt_) do { __builtin_amdgcn_s_setprio(1); _Pragma("unroll") for (int m = 0; m < 4; ++m) _Pragma("unroll") for (int n = 0; n < 2; ++n) _Pragma("unroll") for (int k = 0; k < 2; ++k) \
      acc[ai][bj][m][n] = __builtin_amdgcn_mfma_f32_16x16x32_bf16(Bt_[n][k], At_[m][k], acc[ai][bj][m][n], 0, 0, 0); \
    __builtin_amdgcn_s_setprio(0); } while (0)
#define WAIT_V(n) asm volatile("s_waitcnt vmcnt(" #n ")" ::: "memory")
#define WAIT_L(n) asm volatile("s_waitcnt lgkmcnt(" #n ")" ::: "memory")
#define BAR __builtin_amdgcn_s_barrier()
#define SCHED __builtin_amdgcn_sched_barrier(0)
    const int nM = M / BM, nN = N / BM, nwg = nM * nN, nt = K / BK;
#define UNIT_COORDS(uu, BR, BC) do { int wgid = (uu); \
        { int q = nwg / NXCD, r = nwg % NXCD, xcd = wgid % NXCD, off = wgid / NXCD; wgid = (xcd < r ? xcd * (q + 1) : r * (q + 1) + (xcd - r) * q) + off; } \
        const int nig = WGM * nN, gid = wgid / nig, fm = gid * WGM, gsz = min(nM - fm, WGM); \
        BR = (fm + ((wgid % nig) % gsz)) * BM; BC = ((wgid % nig) / gsz) * BM; } while (0)
    if ((int)blockIdx.x < nwg) {
        int brow, bcol; UNIT_COORDS(blockIdx.x, brow, bcol);
        const char* cA = (const char*)A + (size_t)brow * lda * 2; const char* cB = (const char*)Bt + (size_t)bcol * ldb * 2;
        AccT acc;
#pragma unroll
        for (int a = 0; a < 2; ++a)
#pragma unroll
            for (int b = 0; b < 2; ++b)
#pragma unroll
                for (int m = 0; m < 4; ++m)
#pragma unroll
                    for (int n = 0; n < 2; ++n) acc[a][b][m][n] = (f32x4){0.f, 0.f, 0.f, 0.f};
        bf16x8 At[4][2], B0[2][2], B1[2][2];
        STAGE(SB(0, 0), cB, voffB); STAGE(SB(0, 1), cB + hstepB, voffB); STAGE(SA(0, 0), cA, voffA); STAGE(SA(0, 1), cA + hstepA, voffA);
        if (wr == 1) BAR;
        WAIT_V(2); BAR;
        STAGE(SB(1, 0), cB + kstep, voffB); STAGE(SA(1, 0), cA + kstep, voffA); STAGE(SB(1, 1), cB + hstepB + kstep, voffB);
        WAIT_V(6); BAR;
        for (int u = blockIdx.x;;) {
            const bool has_next = u + (int)gridDim.x < nwg;
            int nbrow = brow, nbcol = bcol;
            if (has_next) UNIT_COORDS(u + gridDim.x, nbrow, nbcol);
            const char* nA = (const char*)A + (size_t)nbrow * lda * 2; const char* nB = (const char*)Bt + (size_t)nbcol * ldb * 2;
#pragma unroll 1
            for (int t = 0; t < nt; t += 2) {
                const bool last = (t == nt - 2);
                const char* a1 = cA + (size_t)(t + 1) * kstep;
                const char* a2 = last ? nA : cA + (size_t)(t + 2) * kstep; const char* b2 = last ? nB : cB + (size_t)(t + 2) * kstep;
                const char* a3 = a2 + kstep; const char* b3 = b2 + kstep;
                LDB(B0, 0, 0); LDB(B1, 0, 1); SCHED; LDA(At, 0, 0); STAGE(SA(1, 1), a1 + hstepA, voffA);
                WAIT_V(8); WAIT_L(0); BAR; MMA(0, 0, At, B0); MMA(0, 1, At, B1); BAR; SCHED;
                LDA(At, 0, 1); STAGE(SB(0, 0), b2, voffB); STAGE(SB(0, 1), b2 + hstepB, voffB); STAGE(SA(0, 0), a2, voffA);
                WAIT_V(8); WAIT_L(0); BAR; MMA(1, 0, At, B0); MMA(1, 1, At, B1); BAR; SCHED;
                LDB(B0, 1, 0); LDB(B1, 1, 1); SCHED; LDA(At, 1, 0); STAGE(SA(0, 1), a2 + hstepA, voffA);
                WAIT_V(8); WAIT_L(0); BAR; MMA(0, 0, At, B0); MMA(0, 1, At, B1); BAR; SCHED;
                LDA(At, 1, 1); STAGE(SB(1, 0), b3, voffB); STAGE(SB(1, 1), b3 + hstepB, voffB); STAGE(SA(1, 0), a3, voffA);
                WAIT_V(8); WAIT_L(0); BAR; MMA(1, 0, At, B0); MMA(1, 1, At, B1); BAR; SCHED;
            }
            if (wr == 0) BAR;
            epi(acc, brow, bcol, wr, wc, fr, fq);
            if (!has_next) break;
#pragma unroll
            for (int a = 0; a < 2; ++a)
#pragma unroll
                for (int b = 0; b < 2; ++b)
#pragma unroll
                    for (int m = 0; m < 4; ++m)
#pragma unroll
                        for (int n = 0; n < 2; ++n) acc[a][b][m][n] = (f32x4){0.f, 0.f, 0.f, 0.f};
            brow = nbrow; bcol = nbcol; cA = nA; cB = nB; u += gridDim.x;
            if (wr == 1) BAR;
        }
        WAIT_V(0);
    }
    __syncthreads();
#undef UNIT_COORDS
}

DI void st_rm_half(const AccT& acc, int bj, bf16_t* O, int ld, int brow, int colbase, float sc, int wr, int wc, int fr, int fq) {
#pragma unroll
    for (int ai = 0; ai < 2; ++ai)
#pragma unroll
        for (int m = 0; m < 4; ++m) {
            const int row = brow + ai * 128 + wr * 64 + m * 16 + fr;
            { const f32x4 v0 = acc[ai][bj][m][0] * sc, v1 = acc[ai][bj][m][1] * sc;
              u32x4 w = {pk2(v0[0], v0[1]), pk2(v0[2], v0[3]), pk2(v1[0], v1[1]), pk2(v1[2], v1[3])};
              *(u32x4*)(O + (long)row * ld + colbase + wc * 32 + fq * 8) = w; }
            asm volatile("" ::: "memory");
        }
}
DI void st_tr_half(const AccT& acc, int bj, bf16_t* VT, int brow, int vcolbase, int wr, int wc, int fr, int fq) {
    const int b = brow / S_, s0 = brow % S_;
#pragma unroll
    for (int ai = 0; ai < 2; ++ai)
#pragma unroll
        for (int m = 0; m < 4; ++m) {
            const int s = s0 + ai * 128 + wr * 64 + m * 16 + fr;
#pragma unroll
            for (int n = 0; n < 2; ++n) {
                const f32x4 v = acc[ai][bj][m][n];
                const int vc = vcolbase + wc * 32 + fq * 8 + n * 4;
                bf16_t* pp = VT + ((long)(b * 1024 + vc)) * S_ + s;
                pp[0] = f2bf(v[0]); pp[(long)S_] = f2bf(v[1]); pp[2L * S_] = f2bf(v[2]); pp[3L * S_] = f2bf(v[3]);
            }
            asm volatile("" ::: "memory");
        }
}

struct EpiGlaIn { bf16_t* Pb; float* GL;
    DI void operator()(const AccT& acc, int brow, int bcol, int wr, int wc, int fr, int fq) const {
        const int pn = bcol >> 8;
        if (pn >= 4 && pn < 8) {
            bf16_t* VT = Pb + GP_VT / 2;
            st_tr_half(acc, 0, VT, brow, bcol - 1024, wr, wc, fr, fq); st_tr_half(acc, 1, VT, brow, bcol - 1024 + 128, wr, wc, fr, fq);
        } else if (pn == 12) {
            if (wc == 0) {
#pragma unroll
                for (int ai = 0; ai < 2; ++ai)
#pragma unroll
                    for (int m = 0; m < 4; ++m) { const int row = brow + ai * 128 + wr * 64 + m * 16 + fr; if (fq < 2) { *(f32x4*)(GL + (long)row * 16 + fq * 8) = acc[ai][0][m][0]; *(f32x4*)(GL + (long)row * 16 + fq * 8 + 4) = acc[ai][0][m][1]; } }
            }
        } else {
            bf16_t* O = Pb + (pn < 2 ? GP_Q / 2 : (pn < 4 ? GP_K / 2 : GP_R / 2));
            const int ld = pn < 4 ? 512 : 1024, cb = pn < 2 ? bcol : (pn < 4 ? bcol - 512 : bcol - 2048);
            st_rm_half(acc, 0, O, ld, brow, cb, 1.f, wr, wc, fr, fq); st_rm_half(acc, 1, O, ld, brow, cb + 128, 1.f, wr, wc, fr, fq);
        }
    }
};
struct EpiRpaIn { bf16_t* Pb; float qscale;
    DI void operator()(const AccT& acc, int brow, int bcol, int wr, int wc, int fr, int fq) const {
        const int pn = bcol >> 8;
        bf16_t* Q = Pb + RP_Q / 2; bf16_t* K = Pb + RP_K / 2; bf16_t* VT = Pb + RP_VT / 2;
        if (pn < 8) { bf16_t* O = pn < 4 ? Q : K; const float sc = pn < 4 ? qscale : 1.f; const int cb = pn < 4 ? bcol : bcol - 1024;
            st_rm_half(acc, 0, O, 1024, brow, cb, sc, wr, wc, fr, fq); st_rm_half(acc, 1, O, 1024, brow, cb + 128, sc, wr, wc, fr, fq); }
        else { st_tr_half(acc, 0, VT, brow, bcol - 2048, wr, wc, fr, fq); st_tr_half(acc, 1, VT, brow, bcol - 2048 + 128, wr, wc, fr, fq); }
    }
};
struct EpiPlain { bf16_t* O; int ld; float sc;
    DI void operator()(const AccT& acc, int brow, int bcol, int wr, int wc, int fr, int fq) const {
        st_rm_half(acc, 0, O, ld, brow, bcol, sc, wr, wc, fr, fq); st_rm_half(acc, 1, O, ld, brow, bcol + 128, sc, wr, wc, fr, fq);
    }
};
struct EpiMlaKv { bf16_t* KN; bf16_t* VT;
    DI void operator()(const AccT& acc, int brow, int bcol, int wr, int wc, int fr, int fq) const {
        const int h = bcol >> 8;
        st_rm_half(acc, 0, KN, 1024, brow, h * 128, 1.f, wr, wc, fr, fq);
        st_tr_half(acc, 1, VT, brow, h * 128, wr, wc, fr, fq);
    }
};
struct EpiSwiglu { bf16_t* Hd;
    DI void operator()(const AccT& acc, int brow, int bcol, int wr, int wc, int fr, int fq) const {
        const int pn = bcol >> 8;
#pragma unroll
        for (int ai = 0; ai < 2; ++ai)
#pragma unroll
            for (int m = 0; m < 4; ++m) {
                const int row = brow + ai * 128 + wr * 64 + m * 16 + fr;
                unsigned wq[4];
#pragma unroll
                for (int n = 0; n < 2; ++n) {
                    const f32x4 gt = acc[ai][0][m][n], up = acc[ai][1][m][n]; float o[4];
#pragma unroll
                    for (int j = 0; j < 4; ++j) { const float x = gt[j]; o[j] = x * __builtin_amdgcn_rcpf(1.f + __expf(-x)) * up[j]; }
                    wq[2 * n] = pk2(o[0], o[1]); wq[2 * n + 1] = pk2(o[2], o[3]);
                }
                *(u32x4*)(Hd + (long)row * FFH + pn * 128 + wc * 32 + fq * 8) = (u32x4){wq[0], wq[1], wq[2], wq[3]};
                asm volatile("" ::: "memory");
            }
    }
};
struct EpiRes { const float* hs; float* out; const float* stat; const float* g; const float* b;
    DI void operator()(const AccT& acc, int brow, int bcol, int wr, int wc, int fr, int fq) const {
        const bool norm = stat != nullptr;
        f32x4 gv[2][2], bv[2][2];
#pragma unroll
        for (int bj = 0; bj < 2; ++bj)
#pragma unroll
            for (int n = 0; n < 2; ++n) {
                const int col = bcol + bj * 128 + wc * 32 + fq * 8 + n * 4;
                gv[bj][n] = norm ? *(const f32x4*)(g + col) : (f32x4){1.f, 1.f, 1.f, 1.f};
                bv[bj][n] = norm ? *(const f32x4*)(b + col) : (f32x4){0.f, 0.f, 0.f, 0.f};
            }
#pragma unroll
        for (int ai = 0; ai < 2; ++ai) {
#pragma unroll
            for (int mh = 0; mh < 2; ++mh) {
                f32x4 hv[2][2][2]; f32x2 sv[2];
#pragma unroll
                for (int mm = 0; mm < 2; ++mm) {
                    const int m = mh * 2 + mm;
                    const int row = brow + ai * 128 + wr * 64 + m * 16 + fr;
                    sv[mm] = norm ? *(const f32x2*)(stat + (long)row * 2) : (f32x2){0.f, 1.f};
#pragma unroll
                    for (int bj = 0; bj < 2; ++bj)
#pragma unroll
                        for (int n = 0; n < 2; ++n) hv[mm][bj][n] = *(const f32x4*)(hs + (long)row * 1024 + bcol + bj * 128 + wc * 32 + fq * 8 + n * 4);
                }
#pragma unroll
                for (int mm = 0; mm < 2; ++mm) {
                    const int m = mh * 2 + mm;
                    const int row = brow + ai * 128 + wr * 64 + m * 16 + fr;
                    const float ra = sv[mm][1], rc = -sv[mm][0] * sv[mm][1];
#pragma unroll
                    for (int bj = 0; bj < 2; ++bj)
#pragma unroll
                        for (int n = 0; n < 2; ++n) {
                            const f32x4 hn = (hv[mm][bj][n] * ra + rc) * gv[bj][n] + bv[bj][n];
                            *(f32x4*)(out + (long)row * 1024 + bcol + bj * 128 + wc * 32 + fq * 8 + n * 4) = hn * ALPHA + acc[ai][bj][m][n];
                        }
                }
                asm volatile("" ::: "memory");
            }
        }
    }
};

constexpr size_t OFF_LNX = 464 * MiB;
constexpr size_t OFF_LNC = 32768;
struct EpiResLN { static constexpr int NVM = 0;
    const float* hs; float* outh; bf16_t* outb; const float* g; const float* b; unsigned long long* xbuf; unsigned* cnt;
    DI void operator()(const AccT& acc, int brow, int bcol, int wr, int wc, int fr, int fq) const {
        AccT z;
        LAS unsigned char* lds = (LAS unsigned char*)smem;
        LAS f32x2* P = (LAS f32x2*)(lds + 131072);
        LAS f32x2* Tb = (LAS f32x2*)(lds + 131072 + 8192);
        const int lane = fq * 16 + fr, tid = (wr * 4 + wc) * 64 + lane;
        const int pm = brow >> 8, pn = bcol >> 8;
#pragma unroll
        for (int ai = 0; ai < 2; ++ai)
#pragma unroll
            for (int m = 0; m < 4; ++m) {
                const int row = brow + ai * 128 + wr * 64 + m * 16 + fr;
                const float* hp = hs + (long)row * 1024 + bcol + wc * 32 + fq * 8;
                float sm = 0.f, sq = 0.f;
#pragma unroll
                for (int bj = 0; bj < 2; ++bj)
#pragma unroll
                    for (int n = 0; n < 2; ++n) {
                        const f32x4 hv = *(const f32x4*)(hp + bj * 128 + n * 4);
                        const f32x4 v = hv * ALPHA + acc[ai][bj][m][n];
                        z[ai][bj][m][n] = v;
                        sm += (v[0] + v[1]) + (v[2] + v[3]); sq += (v[0] * v[0] + v[1] * v[1]) + (v[2] * v[2] + v[3] * v[3]);
                    }
                sm += shx(sm, 16, lane); sq += shx(sq, 16, lane); sm += shx(sm, 32, lane); sq += shx(sq, 32, lane);
                if (fq == 0) P[(ai * 128 + wr * 64 + m * 16 + fr) * 4 + wc] = (f32x2){sm, sq};
                if (m & 1) asm volatile("" ::: "memory");
            }
        __syncthreads();
        if (tid < 256) {
            float sm = 0.f, sq = 0.f;
#pragma unroll
            for (int k = 0; k < 4; ++k) { const f32x2 v = P[tid * 4 + k]; sm += v[0]; sq += v[1]; }
            const unsigned long long pk = (unsigned long long)__float_as_uint(sm) | ((unsigned long long)__float_as_uint(sq) << 32);
            __hip_atomic_store(xbuf + ((long)(pm * 4 + pn) * 256 + tid), pk, __ATOMIC_RELAXED, __HIP_MEMORY_SCOPE_AGENT);
        }
        asm volatile("s_waitcnt vmcnt(0)" ::: "memory");
        __syncthreads();
        if (tid == 0) {
            unsigned* c = cnt + pm * 16;
            __hip_atomic_fetch_add(c, 1u, __ATOMIC_RELAXED, __HIP_MEMORY_SCOPE_AGENT);
            unsigned sp = 0;
            while (__hip_atomic_load(c, __ATOMIC_RELAXED, __HIP_MEMORY_SCOPE_AGENT) < 4u) { __builtin_amdgcn_s_sleep(1); if (++sp > (1u << 22)) break; }
        }
        __syncthreads();
        if (tid < 256) {
            float sm = 0.f, sq = 0.f;
#pragma unroll
            for (int k = 0; k < 4; ++k) {
                const unsigned long long v = __hip_atomic_load(xbuf + ((long)(pm * 4 + k) * 256 + tid), __ATOMIC_RELAXED, __HIP_MEMORY_SCOPE_AGENT);
                sm += __uint_as_float((unsigned)(v & 0xffffffffull)); sq += __uint_as_float((unsigned)(v >> 32));
            }
            const float mu = sm * (1.f / 1024.f), var = fmaxf(sq * (1.f / 1024.f) - mu * mu, 0.f);
            Tb[tid] = (f32x2){mu, 1.0f / sqrtf(var + 1e-5f)};
        }
        __syncthreads();
        f32x4 gv[2][2], bv[2][2];
#pragma unroll
        for (int bj = 0; bj < 2; ++bj)
#pragma unroll
            for (int n = 0; n < 2; ++n) { const int col = bcol + bj * 128 + wc * 32 + fq * 8 + n * 4; gv[bj][n] = *(const f32x4*)(g + col); bv[bj][n] = *(const f32x4*)(b + col); }
#pragma unroll
        for (int ai = 0; ai < 2; ++ai)
#pragma unroll
            for (int m = 0; m < 4; ++m) {
                const int rl = ai * 128 + wr * 64 + m * 16 + fr; const long row = brow + rl;
                const f32x2 t = Tb[rl]; const float ra = t[1], rc = -t[0] * t[1];
#pragma unroll
                for (int bj = 0; bj < 2; ++bj) {
                    const f32x4 y0 = (z[ai][bj][m][0] * ra + rc) * gv[bj][0] + bv[bj][0], y1 = (z[ai][bj][m][1] * ra + rc) * gv[bj][1] + bv[bj][1];
                    const long idx = row * 1024 + bcol + bj * 128 + wc * 32 + fq * 8;
                    *(f32x4*)(outh + idx) = y0; *(f32x4*)(outh + idx + 4) = y1;
                    *(u32x4*)(outb + idx) = (u32x4){pk2(y0[0], y0[1]), pk2(y0[2], y0[3]), pk2(y1[0], y1[1]), pk2(y1[2], y1[3])};
                }
                asm volatile("" ::: "memory");
            }
        __syncthreads();
    }
};

DI void phase_convert(const Params& p, int wv) {
    bf16_t* W = (bf16_t*)(wsptr(p) + OFF_W);
    LAS bf16_t* tile = (LAS bf16_t*)smem;
    const int tid_ = phase_tid(wv); const int tid = tid_;
    for (int t4 = blockIdx.x * 4; t4 < p.conv_tiles; t4 += gridDim.x * 4) {
        int di = 0;
#pragma unroll 1
        for (int i = 1; i < 18; ++i) { int ii = i; asm volatile("" : "+s"(ii)); if (t4 >= p.cd[ii].tile0) di = ii; }
        asm volatile("" : "+s"(di));
        const int K = p.cd[di].K, Nsrc = p.cd[di].Nsrc, perm = p.cd[di].perm, tile0 = p.cd[di].tile0, in_idx = p.cd[di].in_idx;
        const float* src = inptr(p, in_idx) + p.cd[di].src_off;
        bf16_t* dst = W + p.cd[di].dst_off;
        const int ntk = K / 64;
        const int kl = tid >> 4, n4 = (tid & 15) * 4;
        f32x4 v[4][2];
#pragma unroll
        for (int j = 0; j < 4; ++j) {
            const int lt = t4 + j - tile0, kt = lt % ntk, ntile = lt / ntk, k0 = kt * 64, n0 = ntile * 64;
            const int sc0 = perm ? ((n0 & 255) >> 7) * FFH + (n0 >> 8) * 128 + (n0 & 127) : n0;
#pragma unroll
            for (int i = 0; i < 2; ++i) {
                const int k = k0 + kl + 32 * i;
                v[j][i] = (f32x4){0.f, 0.f, 0.f, 0.f};
                if (sc0 + n4 < Nsrc) v[j][i] = *(const f32x4*)(src + (long)k * Nsrc + sc0 + n4);
            }
        }
#pragma unroll
        for (int j = 0; j < 4; ++j)
#pragma unroll
            for (int i = 0; i < 2; ++i)
#pragma unroll
                for (int e = 0; e < 4; ++e) { const int c64 = n4 + e, c = c64 & 31, slot = (c64 & 32) + 16 * ((c >> 2) & 1) + 4 * (c >> 3) + (c & 3); tile[j * 4608 + slot * 72 + kl + 32 * i] = f2bf(v[j][i][e]); }
        __syncthreads();
#pragma unroll
        for (int j = 0; j < 4; ++j) {
            const int lt = t4 + j - tile0, kt = lt % ntk, ntile = lt / ntk, k0 = kt * 64, n0 = ntile * 64;
            const int n = tid >> 3, kc = (tid & 7) * 8;
            const u32x4 w = *(const LAS u32x4*)(tile + j * 4608 + n * 72 + kc);
            *(u32x4*)(dst + (long)(n0 + n) * K + k0 + kc) = w;
        }
        __syncthreads();
    }
    { const float* x = inptr(p, 0); bf16_t* hb = (bf16_t*)(wsptr(p) + OFF_HB);
      const long n8 = (long)T_ * 1024 / 8;
      for (long i = (long)blockIdx.x * NTHR + tid; i < n8; i += (long)gridDim.x * NTHR) {
          const f32x4 a = *(const f32x4*)(x + i * 8), b = *(const f32x4*)(x + i * 8 + 4);
          u32x4 w = {pk2(a[0], a[1]), pk2(a[2], a[3]), pk2(b[0], b[1]), pk2(b[2], b[3])};
          *(u32x4*)(hb + i * 8) = w;
      } }
    { float* ct = (float*)(wsptr(p) + OFF_COS); float* st = (float*)(wsptr(p) + OFF_SIN);
      const float inv = (float)pow(10000.0, -(double)(tid & 31) / 32.0);
      for (int i = blockIdx.x * NTHR + tid; i < S_ * 32; i += gridDim.x * NTHR) {
          const int pos = i >> 5;
          const float ang = (float)pos * inv;
          float sv, cv; sincosf(ang, &sv, &cv); ct[i] = cv; st[i] = sv;
      } }
}

DI void phase_ln(int wv, const float* h, float* hout, bf16_t* hb, float* stat, const float* g, const float* bt, bool final_out) {
    const int tid_ = phase_tid(wv); const int tid = tid_, wid = tid >> 6, lane = tid & 63;
    const int nw = gridDim.x * 8;
    f32x4 gv[4], bv[4];
#pragma unroll
    for (int i = 0; i < 4; ++i) { gv[i] = *(const f32x4*)(g + i * 256 + lane * 4); bv[i] = *(const f32x4*)(bt + i * 256 + lane * 4); }
    for (int row = blockIdx.x * 8 + wid; row < T_; row += nw) {
        f32x4 v[4]; float s = 0.f;
#pragma unroll
        for (int i = 0; i < 4; ++i) { v[i] = *(const f32x4*)(h + (long)row * 1024 + i * 256 + lane * 4); s += (v[i][0] + v[i][1]) + (v[i][2] + v[i][3]); }
#pragma unroll
        for (int o = 32; o >= 1; o >>= 1) s += shx(s, o, lane);
        const float mu = s * (1.f / 1024.f); float q = 0.f;
#pragma unroll
        for (int i = 0; i < 4; ++i) { const f32x4 d = v[i] - mu; q += (d[0] * d[0] + d[1] * d[1]) + (d[2] * d[2] + d[3] * d[3]); }
#pragma unroll
        for (int o = 32; o >= 1; o >>= 1) q += shx(q, o, lane);
        const float rstd = 1.0f / sqrtf(q * (1.f / 1024.f) + 1e-5f);
        const float ra = rstd, rc = -mu * rstd;
        if (final_out) {
#pragma unroll
            for (int i = 0; i < 4; ++i) *(f32x4*)(hout + (long)row * 1024 + i * 256 + lane * 4) = (v[i] * ra + rc) * gv[i] + bv[i];
        } else {
            if (lane == 0) *(f32x2*)(stat + (long)row * 2) = (f32x2){mu, rstd};
#pragma unroll
            for (int i = 0; i < 4; ++i) {
                const f32x4 y = (v[i] * ra + rc) * gv[i] + bv[i];
                u32x2 w = {pk2(y[0], y[1]), pk2(y[2], y[3])};
                *(u32x2*)(hb + (long)row * 1024 + i * 256 + lane * 4) = w;
            }
        }
    }
}

DI void phase_mla_norm(const Params& p, int wv) {
    const int tid_ = phase_tid(wv); const int tid = tid_, wid = tid >> 6, lane = tid & 63;
    bf16_t* C = (bf16_t*)(wsptr(p) + OFF_Y);
    bf16_t* KR = (bf16_t*)(wsptr(p) + OFF_P + MP_KR);
    const float* ct = (const float*)(wsptr(p) + OFF_COS); const float* st = (const float*)(wsptr(p) + OFF_SIN);
    const float* gq = inptr(p, 10); const float* gkv = inptr(p, 11);
    float gqv[6], gkvv[4];
#pragma unroll
    for (int e = 0; e < 6; ++e) gqv[e] = gq[lane * 6 + e];
#pragma unroll
    for (int e = 0; e < 4; ++e) gkvv[e] = gkv[lane * 4 + e];
    const int nw = gridDim.x * 8;
    for (int row = blockIdx.x * 8 + wid; row < T_; row += nw) {
        bf16_t* cr = C + (long)row * 768;
        unsigned* cq = (unsigned*)(cr + lane * 6);
        const unsigned q0 = cq[0], q1 = cq[1], q2 = cq[2];
        float xq[6] = {bflo(q0), bfhi(q0), bflo(q1), bfhi(q1), bflo(q2), bfhi(q2)};
        u32x2* ck = (u32x2*)(cr + 384 + lane * 4);
        const u32x2 kk = *ck;
        float xk[4] = {bflo(kk[0]), bfhi(kk[0]), bflo(kk[1]), bfhi(kk[1])};
        const float tr = bf2f(cr[640 + lane]);
        float sq = 0.f, sk = 0.f;
#pragma unroll
        for (int e = 0; e < 6; ++e) sq += xq[e] * xq[e];
#pragma unroll
        for (int e = 0; e < 4; ++e) sk += xk[e] * xk[e];
#pragma unroll
        for (int o = 32; o >= 1; o >>= 1) { sq += shx(sq, o, lane); sk += shx(sk, o, lane); }
        const float rq = 1.0f / sqrtf(sq * (1.f / 384.f) + 1e-6f), rk = 1.0f / sqrtf(sk * (1.f / 256.f) + 1e-6f);
        cq[0] = pk2(xq[0] * rq * gqv[0], xq[1] * rq * gqv[1]);
        cq[1] = pk2(xq[2] * rq * gqv[2], xq[3] * rq * gqv[3]);
        cq[2] = pk2(xq[4] * rq * gqv[4], xq[5] * rq * gqv[5]);
        u32x2 w = {pk2(xk[0] * rk * gkvv[0], xk[1] * rk * gkvv[1]), pk2(xk[2] * rk * gkvv[2], xk[3] * rk * gkvv[3])};
        *ck = w;
        const float pr = shx(tr, 32, lane);
        const int pos = row % S_, f = lane & 31;
        const float c = ct[pos * 32 + f], s = st[pos * 32 + f];
        const float o = (lane < 32) ? (tr * c - pr * s) : (pr * s + tr * c);
        KR[(long)row * 64 + lane] = f2bf(o);
    }
}

constexpr int MK_STR = 400, MV_STR = 144, MK_BYTES = 64 * MK_STR, MV_BYTES = 128 * MV_STR;
constexpr int MV_BASE = 2 * MK_BYTES, MQR_BASE = MV_BASE + 3 * MV_BYTES;
DI void phase_mla_attn(const Params& p, int wv) {
    LAS unsigned char* lds = (LAS unsigned char*)smem;
    const bf16_t* Q = (const bf16_t*)(wsptr(p) + OFF_P + MP_Q); const bf16_t* KN = (const bf16_t*)(wsptr(p) + OFF_P + MP_KN);
    const bf16_t* VT = (const bf16_t*)(wsptr(p) + OFF_P + MP_VT); const bf16_t* KR = (const bf16_t*)(wsptr(p) + OFF_P + MP_KR);
    bf16_t* Y = (bf16_t*)(wsptr(p) + OFF_Y);
    const float* ct = (const float*)(wsptr(p) + OFF_COS); const float* st = (const float*)(wsptr(p) + OFF_SIN);
    const int tid_ = phase_tid(wv); const int tid = tid_, wid = __builtin_amdgcn_readfirstlane(tid >> 6), lane = tid & 63, l32 = lane & 31, g = lane >> 5;
    const int G = gridDim.x, vcu = vcu_of_block();
    const bool grpB = wid >= 4;
    for (int pi = vcu; pi < 512; pi += G) {
        const int bh = pi >> 5, pp = pi & 31, b = bh >> 3, h = bh & 7;
        for (int half = 0; half < 2; ++half) {
            const int qt = half ? pp : (63 - pp);
            const int cq = qt * 4 + (wid >> 1), ntiles = qt * 4 + 4;
            bf16x8 q[6];
            LAS unsigned char* qr = lds + MQR_BASE + wid * 6144 + lane * 16;
            { const char* qpb = (const char*)(Q + ((long)b * S_ + qt * 256) * 1536 + h * 192);
              const unsigned qoff = (unsigned)((wid * 32 + l32) * 1536 + g * 8) * 2u;
              bf16x8 qro[4];
#pragma unroll
              for (int s = 0; s < 4; ++s) qro[s] = *(const bf16x8*)(qpb + qoff + 32 * (8 + s));
#pragma unroll
              for (int s = 0; s < 6; ++s) q[s] = *(const bf16x8*)(qpb + qoff + 32 * s);
#pragma unroll
              for (int s = 6; s < 8; ++s) *(LAS bf16x8*)(qr + (s - 2) * 1024) = *(const bf16x8*)(qpb + qoff + 32 * s);
              const char* ctb = (const char*)(ct + (long)qt * 256 * 32); const char* stb = (const char*)(st + (long)qt * 256 * 32);
              const unsigned toff = (unsigned)((wid * 32 + l32) * 32 + 8 * g) * 4u;
#pragma unroll
              for (int ss = 0; ss < 2; ++ss) {
                  const f32x4 c0 = *(const f32x4*)(ctb + toff + 64 * ss), c1 = *(const f32x4*)(ctb + toff + 64 * ss + 16);
                  const f32x4 s0 = *(const f32x4*)(stb + toff + 64 * ss), s1 = *(const f32x4*)(stb + toff + 64 * ss + 16);
                  float o1[8], o2[8];
#pragma unroll
                  for (int e = 0; e < 8; ++e) {
                      const float c = e < 4 ? c0[e & 3] : c1[e & 3], s = e < 4 ? s0[e & 3] : s1[e & 3];
                      const float t1 = bf2f((unsigned short)qro[ss][e]), t2 = bf2f((unsigned short)qro[2 + ss][e]);
                      o1[e] = t1 * c - t2 * s; o2[e] = t1 * s + t2 * c;
                  }
                  *(LAS bf16x8*)(qr + ss * 1024) = pack8(o1[0], o1[1], o1[2], o1[3], o1[4], o1[5], o1[6], o1[7]);
                  *(LAS bf16x8*)(qr + (2 + ss) * 1024) = pack8(o2[0], o2[1], o2[2], o2[3], o2[4], o2[5], o2[6], o2[7]);
              } }
            f32x16 o[4]; for (int i = 0; i < 4; ++i) o[i] = zero16();
            float mrun = -1e30f, lsum = 0.f;
            u32x4 kreg[3], vreg[2];
            const long key_base = (long)b * S_;
            const unsigned kn_off = (unsigned)((tid >> 4) * 1024 + (tid & 15) * 8) * 2u, kr_off = (unsigned)((tid >> 3) * 64 + (tid & 7) * 8) * 2u, vt_off = (unsigned)((tid >> 3) * S_ + (tid & 7) * 8) * 2u;
#define MLA_GLOAD(kt) do { const long k0 = key_base + (long)(kt) * 64; \
    const char* knb = (const char*)(KN + k0 * 1024 + h * 128); const char* krb = (const char*)(KR + k0 * 64); \
    const char* vtb = (const char*)(VT + ((long)(b * 1024 + h * 128)) * S_ + (long)(kt) * 64); \
    kreg[0] = *(const u32x4*)(knb + kn_off); kreg[1] = *(const u32x4*)(knb + 65536 + kn_off); \
    kreg[2] = *(const u32x4*)(krb + kr_off); \
    vreg[0] = *(const u32x4*)(vtb + vt_off); vreg[1] = *(const u32x4*)(vtb + 64L * S_ * 2 + vt_off); } while (0)
#define MLA_LWRITE(kbufp, vbufp) do { LAS unsigned char* _kp = (kbufp); LAS unsigned char* _vp = (vbufp); \
    { const int id = tid; *(LAS u32x4*)(_kp + (id >> 4) * MK_STR + (id & 15) * 16) = kreg[0]; } \
    { const int id = tid + 512; *(LAS u32x4*)(_kp + (id >> 4) * MK_STR + (id & 15) * 16) = kreg[1]; } \
    *(LAS u32x4*)(_kp + (tid >> 3) * MK_STR + 256 + (tid & 7) * 16) = kreg[2]; \
    { const int id = tid; *(LAS u32x4*)(_vp + (id >> 3) * MV_STR + (id & 7) * 16) = vreg[0]; } \
    { const int id = tid + 512; *(LAS u32x4*)(_vp + (id >> 3) * MV_STR + (id & 7) * 16) = vreg[1]; } } while (0)
            auto do_qk = [&](f32x16& s0, f32x16& s1, LAS unsigned char* kbuf) {
                s0 = zero16(); s1 = zero16();
                LAS unsigned char* kb = kbuf + ((l32 & 19) | ((l32 & 4) << 1) | ((l32 & 8) >> 1)) * MK_STR + g * 16;
                __builtin_amdgcn_s_setprio(1);
#pragma unroll
                for (int s = 0; s < 12; ++s) {
                    const bf16x8 a0 = *(const LAS bf16x8*)(kb + s * 32), a1 = *(const LAS bf16x8*)(kb + 32 * MK_STR + s * 32);
                    const bf16x8 qv = (s < 6) ? q[s < 6 ? s : 0] : *(const LAS bf16x8*)(qr + (s < 8 ? s - 2 : s - 8) * 1024);
                    s0 = MFMA32(a0, qv, s0); s1 = MFMA32(a1, qv, s1);
                }
                __builtin_amdgcn_s_setprio(0);
            };
            auto do_sm_pv = [&](f32x16& s0, f32x16& s1, LAS unsigned char* vbuf) {
                float mx = s0[0];
#pragma unroll
                for (int i = 0; i < 16; ++i) { mx = fmaxf(mx, s0[i]); mx = fmaxf(mx, s1[i]); }
                mx = xh_max(mx);
                const bool fire = __builtin_amdgcn_ballot_w64(mx - mrun > 8.0f) != 0ull;
                const float mnew = fire ? fmaxf(mrun, mx) : mrun, alpha = __builtin_amdgcn_exp2f(mrun - mnew);
                mrun = mnew;
                float ps = 0.f;
#pragma unroll
                for (int i = 0; i < 16; ++i) { s0[i] = __builtin_amdgcn_exp2f(s0[i] - mnew); s1[i] = __builtin_amdgcn_exp2f(s1[i] - mnew); ps += s0[i] + s1[i]; }
                lsum = lsum * alpha + ps;
                if (fire) {
#pragma unroll
                    for (int t = 0; t < 4; ++t) o[t] = o[t] * alpha;
                }
                bf16x8 pb[4] = {pack_lo(s0), pack_hi(s0), pack_lo(s1), pack_hi(s1)};
                LAS unsigned char* vb = vbuf + l32 * MV_STR + g * 16;
                __builtin_amdgcn_s_setprio(1);
#pragma unroll
                for (int dvt = 0; dvt < 4; ++dvt)
#pragma unroll
                    for (int ss = 0; ss < 4; ++ss) {
                        const bf16x8 a8 = *(const LAS bf16x8*)(vb + dvt * 32 * MV_STR + ss * 32);
                        o[dvt] = MFMA32(a8, pb[ss], o[dvt]);
                    }
                __builtin_amdgcn_s_setprio(0);
            };
            const bool rev = half != 0;
#define KT(i) (rev ? (ntiles - 1 - (i)) : (i))
            MLA_GLOAD(KT(0)); MLA_LWRITE(lds, lds + MV_BASE); __syncthreads();
            if (!grpB) {
                int vcur = 0;
                for (int i = 0; i < ntiles; ++i) {
                    const int vnext = vcur == 2 ? 0 : vcur + 1;
                    if (i + 1 < ntiles) MLA_GLOAD(KT(i + 1));
                    if (KT(i) <= cq) { f32x16 s0, s1; do_qk(s0, s1, lds + (i & 1) * MK_BYTES); do_sm_pv(s0, s1, lds + MV_BASE + vcur * MV_BYTES); }
                    if (i + 1 < ntiles) MLA_LWRITE(lds + ((i + 1) & 1) * MK_BYTES, lds + MV_BASE + vnext * MV_BYTES);
                    __syncthreads();
                    vcur = vnext;
                }
            } else {
                int vcur = 0;
                f32x16 s0 = zero16(), s1 = zero16();
                for (int i = 0; i < ntiles; ++i) {
                    const int vprev = vcur == 0 ? 2 : vcur - 1, vnext = vcur == 2 ? 0 : vcur + 1;
                    if (i + 1 < ntiles) MLA_GLOAD(KT(i + 1));
                    if (i >= 1 && KT(i - 1) <= cq) do_sm_pv(s0, s1, lds + MV_BASE + vprev * MV_BYTES);
                    if (KT(i) <= cq) do_qk(s0, s1, lds + (i & 1) * MK_BYTES);
                    if (i + 1 < ntiles) MLA_LWRITE(lds + ((i + 1) & 1) * MK_BYTES, lds + MV_BASE + vnext * MV_BYTES);
                    __syncthreads();
                    vcur = vnext;
                }
                if (KT(ntiles - 1) <= cq) { const int vlast = vcur == 0 ? 2 : vcur - 1; do_sm_pv(s0, s1, lds + MV_BASE + vlast * MV_BYTES); }
            }
#undef KT
            const float ltot = xh_sum(lsum), inv = 1.f / ltot;
            char* ypb = (char*)(Y + ((long)b * S_ + qt * 256) * 1024 + h * 128);
            const unsigned yoff = (unsigned)((wid * 32 + l32) * 1024 + 4 * g) * 2u;
#pragma unroll
            for (int dvt = 0; dvt < 4; ++dvt)
#pragma unroll
                for (int a = 0; a < 4; ++a) {
                    u32x2 w = {pk2(o[dvt][4 * a] * inv, o[dvt][4 * a + 1] * inv), pk2(o[dvt][4 * a + 2] * inv, o[dvt][4 * a + 3] * inv)};
                    *(u32x2*)(ypb + yoff + (dvt * 32 + a * 8) * 2) = w;
                }
            __syncthreads();
        }
    }
#undef MLA_GLOAD
#undef MLA_LWRITE
}

constexpr int RK_STR = 144, RV_STR = 136, RK_BYTES = 64 * RK_STR, RV_BYTES = 64 * RV_STR, RBUF = RK_BYTES + RV_BYTES, R_BIAS_OFF = 3 * RBUF;
DI void phase_rpa_attn(const Params& p, int wv) {
    LAS unsigned char* lds = (LAS unsigned char*)smem;
    const bf16_t* Q = (const bf16_t*)(wsptr(p) + OFF_P + RP_Q); const bf16_t* Kp = (const bf16_t*)(wsptr(p) + OFF_P + RP_K);
    const bf16_t* VT = (const bf16_t*)(wsptr(p) + OFF_P + RP_VT);
    bf16_t* Y = (bf16_t*)(wsptr(p) + OFF_Y);
    const float* relb = inptr(p, 7);
    LAS float* bias = (LAS float*)(lds + R_BIAS_OFF);
    const int tid_ = phase_tid(wv); const int tid = tid_, wid = __builtin_amdgcn_readfirstlane(tid >> 6), lane = tid & 63, l32 = lane & 31, g = lane >> 5;
    const int G = gridDim.x, vcu = vcu_of_block();
    for (int u = vcu; u < 2048; u += G) {
        const int bh = u >> 6, grp = u & 63, b = bh >> 4, h = bh & 15;
        const int c = grp * 4 + (wid >> 1);
        const int qi = (wid & 1) * 32 + l32;
        const long tok = (long)b * S_ + c * 64 + qi;
        bf16x8 q[4];
        { const bf16_t* qp = Q + tok * 1024 + h * 64 + g * 8;
#pragma unroll
          for (int s = 0; s < 4; ++s) q[s] = *(const bf16x8*)(qp + 16 * s); }
        if (tid < 257) bias[tid] = relb[h * 257 + tid] * LOG2E;
        f32x16 o[2] = {zero16(), zero16()};
        float mrun = -1e30f, lsum = 0.f;
        u32x4 kreg0, vreg0, kreg1, vreg1;
        const unsigned rk_off = (unsigned)((tid >> 3) * 1024 + (tid & 7) * 8) * 2u, rv_off = (unsigned)((tid >> 3) * S_ + (tid & 7) * 8) * 2u;
        const int kc0 = max(0, grp * 4 - 8), kc1 = grp * 4 + 3, ntl = kc1 - kc0 + 1;
#define RPA_GLOAD(kc, KR_, VR_) do { const long k0 = (long)b * S_ + (long)(kc) * 64; \
    const char* kb_ = (const char*)(Kp + k0 * 1024 + h * 64); const char* vtb = (const char*)(VT + ((long)(b * 1024 + h * 64)) * S_ + (long)(kc) * 64); \
    KR_ = *(const u32x4*)(kb_ + rk_off); VR_ = *(const u32x4*)(vtb + rv_off); } while (0)
#define RPA_LWRITE(bufp, KR_, VR_) do { LAS unsigned char* _bp = (bufp); \
    *(LAS u32x4*)(_bp + (tid >> 3) * RK_STR + (tid & 7) * 16) = KR_; \
    { LAS unsigned char* a = _bp + RK_BYTES + (tid >> 3) * RV_STR + (tid & 7) * 16; \
      *(LAS u32x2*)a = (u32x2){VR_[0], VR_[1]}; *(LAS u32x2*)(a + 8) = (u32x2){VR_[2], VR_[3]}; } } while (0)
        auto tile = [&](int kc, LAS unsigned char* buf) {
            if (kc <= c && kc >= c - 8) {
                f32x16 s0 = zero16(), s1 = zero16();
                LAS unsigned char* kb = buf + l32 * RK_STR + g * 16;
#pragma unroll
                for (int s = 0; s < 4; ++s) {
                    const bf16x8 a0 = *(const LAS bf16x8*)(kb + s * 32), a1 = *(const LAS bf16x8*)(kb + 32 * RK_STR + s * 32);
                    s0 = MFMA32(a0, q[s], s0); s1 = MFMA32(a1, q[s], s1);
                }
                const int dist = c - kc;
                if (dist >= 3) {
                    const float bc = bias[256];
#pragma unroll
                    for (int i = 0; i < 16; ++i) { s0[i] += bc; s1[i] += bc; }
                } else {
                    const int base = dist * 64 + qi - 4 * g;
#pragma unroll
                    for (int i = 0; i < 16; ++i) {
                        const int kj = 8 * (i >> 2) + (i & 3);
                        const int r0 = base - kj, r1 = base - kj - 32;
                        s0[i] += bias[min(r0, 128) + 128]; s1[i] += bias[min(r1, 128) + 128];
                    }
                }
                float mx = s0[0];
#pragma unroll
                for (int i = 0; i < 16; ++i) { mx = fmaxf(mx, s0[i]); mx = fmaxf(mx, s1[i]); }
                mx = xh_max(mx);
                if (__builtin_amdgcn_ballot_w64(mx - mrun > 8.0f) != 0ull) {
                    const float mnew = fmaxf(mrun, mx), alpha = __builtin_amdgcn_exp2f(mrun - mnew); mrun = mnew;
                    lsum *= alpha; o[0] = o[0] * alpha; o[1] = o[1] * alpha;
                }
                float ps = 0.f;
#pragma unroll
                for (int i = 0; i < 16; ++i) { s0[i] = __builtin_amdgcn_exp2f(s0[i] - mrun); s1[i] = __builtin_amdgcn_exp2f(s1[i] - mrun); ps += s0[i] + s1[i]; }
                lsum += ps;
                bf16x8 pb[4] = {pack_lo(s0), pack_hi(s0), pack_lo(s1), pack_hi(s1)};
                LAS unsigned char* vb = buf + RK_BYTES + l32 * RV_STR + g * 8;
#pragma unroll
                for (int dvt = 0; dvt < 2; ++dvt)
#pragma unroll
                    for (int ss = 0; ss < 4; ++ss) {
                        const u32x2 lo = *(const LAS u32x2*)(vb + dvt * 32 * RV_STR + ss * 32), hi = *(const LAS u32x2*)(vb + dvt * 32 * RV_STR + ss * 32 + 16);
                        u32x4 a4 = {lo[0], lo[1], hi[0], hi[1]};
                        o[dvt] = MFMA32(__builtin_bit_cast(bf16x8, a4), pb[ss], o[dvt]);
                    }
            }
        };
        RPA_GLOAD(kc0, kreg0, vreg0); RPA_GLOAD(kc0 + 1, kreg1, vreg1);
        RPA_LWRITE(lds, kreg0, vreg0); __syncthreads();
        int slot = 0;
        for (int it = 0; it < ntl; it += 2) {
            const int s1_ = slot == 2 ? 0 : slot + 1, s2_ = s1_ == 2 ? 0 : s1_ + 1;
            if (it + 2 < ntl) RPA_GLOAD(kc0 + it + 2, kreg0, vreg0);
            tile(kc0 + it, lds + slot * RBUF);
            RPA_LWRITE(lds + s1_ * RBUF, kreg1, vreg1);
            __syncthreads();
            if (it + 3 < ntl) RPA_GLOAD(kc0 + it + 3, kreg1, vreg1);
            tile(kc0 + it + 1, lds + s1_ * RBUF);
            if (it + 2 < ntl) RPA_LWRITE(lds + s2_ * RBUF, kreg0, vreg0);
            __syncthreads();
            slot = s2_;
        }
        const float ltot = xh_sum(lsum), inv = 1.f / ltot;
        bf16_t* yp = Y + tok * 1024 + h * 64 + 4 * g;
#pragma unroll
        for (int dvt = 0; dvt < 2; ++dvt)
#pragma unroll
            for (int a = 0; a < 4; ++a) {
                u32x2 w = {pk2(o[dvt][4 * a] * inv, o[dvt][4 * a + 1] * inv), pk2(o[dvt][4 * a + 2] * inv, o[dvt][4 * a + 3] * inv)};
                *(u32x2*)(yp + dvt * 32 + a * 8) = w;
            }
    }
}

DI void phase_gla_prep(const Params& p, int wv, int j) {
    LAS float* gl = (LAS float*)smem;
    LAS float* part = gl + 1024;
    bf16_t* Pb = (bf16_t*)(wsptr(p) + OFF_P);
    bf16_t* Q = Pb + GP_Q / 2; bf16_t* K = Pb + GP_K / 2; bf16_t* KT = Pb + GP_KT / 2;
    const float* GL = (const float*)(wsptr(p) + OFF_P + GP_GL);
    float* decay = (float*)(wsptr(p) + OFF_DECAY);
    const float* wg = inptr(p, 2) + (long)j * 16 * 512; const float* bg = inptr(p, 3) + (long)j * 512;
    const int tid_ = phase_tid(wv); const int tid = tid_, d0 = (tid & 63) * 2, tq = tid >> 6;
    f32x4 ngl = {0.f, 0.f, 0.f, 0.f}; f32x2 nw[16]; f32x2 nbg = {0.f, 0.f}; unsigned nqw[8], nkw[8];
#define GP_LOAD(uu) do { const int h_ = (uu) & 3, bc_ = (uu) >> 2, b_ = bc_ >> 8, c_ = bc_ & 255; const long t0_ = (long)b_ * S_ + c_ * 64; \
    if (tid < 256) ngl = *(const f32x4*)(GL + t0_ * 16 + tid * 4); \
    _Pragma("unroll") for (int r = 0; r < 16; ++r) nw[r] = *(const f32x2*)(wg + r * 512 + h_ * 128 + d0); \
    nbg = *(const f32x2*)(bg + h_ * 128 + d0); \
    _Pragma("unroll") for (int i = 0; i < 8; ++i) { const long idx_ = (t0_ + tq * 8 + i) * 512 + h_ * 128 + d0; nqw[i] = *(const unsigned*)(Q + idx_); nkw[i] = *(const unsigned*)(K + idx_); } } while (0)
    if ((int)blockIdx.x < 2048) GP_LOAD(blockIdx.x);
    for (int u = blockIdx.x; u < 2048; u += gridDim.x) {
        const int h = u & 3, bc = u >> 2, b = bc >> 8, c = bc & 255;
        const long tok0 = (long)b * S_ + c * 64;
        if (tid < 256) *(LAS f32x4*)(gl + tid * 4) = ngl;
        f32x2 w[16]; unsigned qw8[8], kw8[8];
#pragma unroll
        for (int r = 0; r < 16; ++r) w[r] = nw[r];
#pragma unroll
        for (int i = 0; i < 8; ++i) { qw8[i] = nqw[i]; kw8[i] = nkw[i]; }
        const f32x2 bgv = nbg;
        __syncthreads();
        f32x2 la[8]; f32x2 run = {0.f, 0.f};
#pragma unroll
        for (int i = 0; i < 8; ++i) {
            const int t = tq * 8 + i; f32x2 lg = bgv;
#pragma unroll
            for (int r4 = 0; r4 < 4; ++r4) { const f32x4 gq = *(const LAS f32x4*)(gl + t * 16 + 4 * r4);
                lg += w[4 * r4] * gq[0] + w[4 * r4 + 1] * gq[1] + w[4 * r4 + 2] * gq[2] + w[4 * r4 + 3] * gq[3]; }
            f32x2 ls;
            ls[0] = fminf(lg[0], 0.f) - __logf(1.f + __expf(-fabsf(lg[0])));
            ls[1] = fminf(lg[1], 0.f) - __logf(1.f + __expf(-fabsf(lg[1])));
            run += ls * (1.f / 16.f); la[i] = run;
        }
        *(LAS f32x2*)(part + tq * 128 + d0) = run;
        __syncthreads();
        if (u + (int)gridDim.x < 2048) GP_LOAD(u + gridDim.x);
        f32x2 off = {0.f, 0.f}, tot = {0.f, 0.f};
#pragma unroll
        for (int k = 0; k < 8; ++k) { const f32x2 v = *(const LAS f32x2*)(part + k * 128 + d0); tot += v; if (k < tq) off += v; }
        unsigned kt0[4], kt1[4];
        float kp0 = 0.f, kp1 = 0.f;
#pragma unroll
        for (int i = 0; i < 8; ++i) {
            const int t = tq * 8 + i; const f32x2 cum = la[i] + off;
            const long idx = (tok0 + t) * 512 + h * 128 + d0;
            const unsigned qw = qw8[i], kw = kw8[i];
            const float q0 = bflo(qw) * 0.08838834764831845f * __expf(cum[0]), q1 = bfhi(qw) * 0.08838834764831845f * __expf(cum[1]);
            const float k0 = bflo(kw) * __expf(-cum[0]), k1 = bfhi(kw) * __expf(-cum[1]);
            *(unsigned*)(Q + idx) = pk2(q0, q1); *(unsigned*)(K + idx) = pk2(k0, k1);
            if (i & 1) { kt0[i >> 1] = pk2(kp0, k0); kt1[i >> 1] = pk2(kp1, k1); } else { kp0 = k0; kp1 = k1; }
        }
        { bf16_t* ktp = KT + ((long)(b * 512 + h * 128 + d0)) * S_ + c * 64 + tq * 8;
          *(u32x4*)ktp = (u32x4){kt0[0], kt0[1], kt0[2], kt0[3]}; *(u32x4*)(ktp + S_) = (u32x4){kt1[0], kt1[1], kt1[2], kt1[3]}; }
        if (tq == 7) *(f32x2*)(decay + ((long)(b * NCH + c)) * 512 + h * 128 + d0) = (f32x2){__expf(tot[0]), __expf(tot[1])};
        __syncthreads();
    }
#undef GP_LOAD
}

constexpr int GQ_STR = 264, GK_STR = 144, GQ_BYTES = 64 * GQ_STR, GK_BYTES = 128 * GK_STR, GBUF = GQ_BYTES + GK_BYTES + 512;
constexpr int NSEG = 32, SEGC = NCH / NSEG;
constexpr size_t OFF_X = OFF_HB, OFF_DS = OFF_HB + 40 * MiB;
template <bool WITH_O>
DI void phase_gla_scan(const Params& p, int wv) {
    LAS unsigned char* lds = (LAS unsigned char*)smem;
    const bf16_t* Pb = (const bf16_t*)(wsptr(p) + OFF_P);
    const bf16_t* Q = Pb + GP_Q / 2; const bf16_t* KT = Pb + GP_KT / 2; const bf16_t* VT = Pb + GP_VT / 2;
    const float* decay = (const float*)(wsptr(p) + OFF_DECAY);
    float* X = (float*)(wsptr(p) + OFF_X); float* DS = (float*)(wsptr(p) + OFF_DS);
    bf16_t* Y = (bf16_t*)(wsptr(p) + OFF_Y);
    const int tid_ = phase_tid(wv); const int tid = tid_, wid = __builtin_amdgcn_readfirstlane(tid >> 6), lane = tid & 63, l32 = lane & 31, g = lane >> 5;
    for (int u = blockIdx.x; u < 8 * NSEG; u += gridDim.x) {
        const int bh = u / NSEG, seg = u % NSEG, b = bh >> 2, h = bh & 3;
        const int c0 = seg * SEGC;
        const int dvc = h * 256 + wid * 32 + l32;
        f32x16 St[4]; bf16x8 Sb[8];
        float* xw = X + ((long)(bh * NSEG + seg)) * 32768 + wid * 4096 + lane;
        if (WITH_O) {
#pragma unroll
            for (int t = 0; t < 4; ++t) {
#pragma unroll
                for (int i = 0; i < 16; ++i) St[t][i] = xw[(t * 16 + i) * 64];
                Sb[2 * t] = pack_lo(St[t]); Sb[2 * t + 1] = pack_hi(St[t]);
            }
        } else {
            for (int t = 0; t < 4; ++t) St[t] = zero16();
            for (int s = 0; s < 8; ++s) Sb[s] = (bf16x8){0, 0, 0, 0, 0, 0, 0, 0};
            if (tid < 128) {
                float dp = 1.f;
                for (int c = 0; c < SEGC; ++c) dp *= decay[((long)(b * NCH + c0 + c)) * 512 + h * 128 + tid];
                DS[(bh * NSEG + seg) * 128 + tid] = dp;
            }
        }
        u32x4 qreg[2], kreg[2]; f32x4 dreg; bf16x8 vcur[4], vnext[4];
        const unsigned gq_off = (unsigned)((tid >> 4) * 512 + (tid & 15) * 8) * 2u, gk_off = (unsigned)((tid >> 3) * S_ + (tid & 7) * 8) * 2u, gv_off = (unsigned)(l32 * S_ + 8 * g) * 2u;
#define GLA_GLOAD(c) do { const long t0 = (long)b * S_ + (long)(c) * 64; \
    const char* qb_ = (const char*)(Q + t0 * 512 + h * 128); const char* ktb = (const char*)(KT + ((long)(b * 512 + h * 128)) * S_ + (long)(c) * 64); \
    const char* vtb = (const char*)(VT + ((long)(b * 1024 + h * 256 + wid * 32)) * S_ + (long)(c) * 64); \
    if (WITH_O) { qreg[0] = *(const u32x4*)(qb_ + gq_off); qreg[1] = *(const u32x4*)(qb_ + 32768 + gq_off); } \
    kreg[0] = *(const u32x4*)(ktb + gk_off); kreg[1] = *(const u32x4*)(ktb + 64L * S_ * 2 + gk_off); \
    if (tid < 32) dreg = *(const f32x4*)(decay + ((long)(b * NCH + (c))) * 512 + h * 128 + tid * 4); \
    _Pragma("unroll") for (int ks = 0; ks < 4; ++ks) vnext[ks] = *(const bf16x8*)(vtb + gv_off + ks * 32); } while (0)
#define GLA_LWRITE(bufp) do { LAS unsigned char* _bp = (bufp); \
    if (WITH_O) { { const int id = tid; LAS unsigned char* a = _bp + (id >> 4) * GQ_STR + (id & 15) * 16; \
      *(LAS u32x2*)a = (u32x2){qreg[0][0], qreg[0][1]}; *(LAS u32x2*)(a + 8) = (u32x2){qreg[0][2], qreg[0][3]}; } \
    { const int id = tid + 512; LAS unsigned char* a = _bp + (id >> 4) * GQ_STR + (id & 15) * 16; \
      *(LAS u32x2*)a = (u32x2){qreg[1][0], qreg[1][1]}; *(LAS u32x2*)(a + 8) = (u32x2){qreg[1][2], qreg[1][3]}; } } \
    { const int id = tid; *(LAS u32x4*)(_bp + GQ_BYTES + (id >> 3) * GK_STR + (id & 7) * 16) = kreg[0]; } \
    { const int id = tid + 512; *(LAS u32x4*)(_bp + GQ_BYTES + (id >> 3) * GK_STR + (id & 7) * 16) = kreg[1]; } \
    if (tid < 32) *(LAS f32x4*)(_bp + GQ_BYTES + GK_BYTES + tid * 16) = dreg; } while (0)
        GLA_GLOAD(c0); GLA_LWRITE(lds);
#pragma unroll
        for (int ks = 0; ks < 4; ++ks) vcur[ks] = vnext[ks];
        __syncthreads();
        for (int ci = 0; ci < SEGC; ++ci) {
            const int c = c0 + ci;
            LAS unsigned char* buf = lds + (ci & 1) * GBUF;
            if (ci + 1 < SEGC) GLA_GLOAD(c + 1);
            if (WITH_O) {
#pragma unroll
                for (int qt = 0; qt < 2; ++qt) {
                    f32x16 acc = zero16();
                    LAS unsigned char* qb = buf + (32 * qt + l32) * GQ_STR + g * 8;
#pragma unroll
                    for (int s = 0; s < 8; ++s) {
                        const u32x2 lo = *(const LAS u32x2*)(qb + s * 32), hi = *(const LAS u32x2*)(qb + s * 32 + 16);
                        u32x4 a4 = {lo[0], lo[1], hi[0], hi[1]};
                        acc = MFMA32(__builtin_bit_cast(bf16x8, a4), Sb[s], acc);
                    }
                    bf16_t* yp = Y + ((long)b * S_ + c * 64 + 32 * qt + 4 * g) * 1024 + dvc;
#pragma unroll
                    for (int i = 0; i < 16; ++i) yp[(long)(8 * (i >> 2) + (i & 3)) * 1024] = f2bf(acc[i]);
                }
            }
#pragma unroll
            for (int t = 0; t < 4; ++t) {
                LAS unsigned char* kb = buf + GQ_BYTES + (32 * t + l32) * GK_STR + g * 16;
#pragma unroll
                for (int ks = 0; ks < 4; ++ks) {
                    const bf16x8 a = *(const LAS bf16x8*)(kb + ks * 32);
                    St[t] = MFMA32(a, vcur[ks], St[t]);
                }
                LAS unsigned char* db = buf + GQ_BYTES + GK_BYTES + (32 * t + 4 * g) * 4;
#pragma unroll
                for (int a = 0; a < 4; ++a) {
                    const f32x4 d4 = *(const LAS f32x4*)(db + a * 32);
#pragma unroll
                    for (int jj = 0; jj < 4; ++jj) St[t][4 * a + jj] *= d4[jj];
                }
                if (WITH_O) { Sb[2 * t] = pack_lo(St[t]); Sb[2 * t + 1] = pack_hi(St[t]); }
            }
            if (ci + 1 < SEGC) { GLA_LWRITE(lds + ((ci + 1) & 1) * GBUF);
#pragma unroll
                for (int ks = 0; ks < 4; ++ks) vcur[ks] = vnext[ks]; }
            __syncthreads();
        }
        if (!WITH_O) {
#pragma unroll
            for (int t = 0; t < 4; ++t)
#pragma unroll
                for (int i = 0; i < 16; ++i) xw[(t * 16 + i) * 64] = St[t][i];
        }
    }
#undef GLA_GLOAD
#undef GLA_LWRITE
}
DI void phase_gla_combine(const Params& p, int wv) {
    float* X = (float*)(wsptr(p) + OFF_X); const float* DS = (const float*)(wsptr(p) + OFF_DS);
    const int tid_ = phase_tid(wv); const int tid = tid_;
    for (int idx = blockIdx.x * NTHR + tid; idx < 8 * 32768; idx += gridDim.x * NTHR) {
        const int bh = idx >> 15, e = idx & 32767;
        const int lane = e & 63, ti = (e >> 6) & 63, t = ti >> 4, i = ti & 15;
        const int dk = 32 * t + 8 * (i >> 2) + 4 * (lane >> 5) + (i & 3);
        float r = 0.f;
        float* xp = X + (long)bh * NSEG * 32768 + e;
        const float* dp = DS + bh * NSEG * 128 + dk;
#pragma unroll 4
        for (int seg = 0; seg < NSEG; ++seg) {
            const float tmp = xp[(long)seg * 32768], D = dp[seg * 128];
            xp[(long)seg * 32768] = r;
            r = r * D + tmp;
        }
    }
}

constexpr int OQ_STR = 272, OV_STR = 144, OQ_BYTES = 64 * OQ_STR, OV_BYTES = 256 * OV_STR, O_XS_OFF = 2 * OQ_BYTES + OV_BYTES;
DI void phase_gla_out(const Params& p, int wv, int j) {
    LAS unsigned char* lds = (LAS unsigned char*)smem;
    LAS float* OL = (LAS float*)(lds + O_XS_OFF);
    const bf16_t* Pb = (const bf16_t*)(wsptr(p) + OFF_P);
    const bf16_t* Q = Pb + GP_Q / 2; const bf16_t* K = Pb + GP_K / 2; const bf16_t* VT = Pb + GP_VT / 2; const bf16_t* R = Pb + GP_R / 2;
    bf16_t* Y = (bf16_t*)(wsptr(p) + OFF_Y);
    const float* ng = inptr(p, 4) + (long)j * 1024;
    const int tid_ = phase_tid(wv); const int tid = tid_, wid = __builtin_amdgcn_readfirstlane(tid >> 6), lane = tid & 63, l32 = lane & 31, g = lane >> 5;
    const int qt = wid & 1, dq = wid >> 1;
    const int qi = 32 * qt + l32;
    const int krow = (l32 & 19) | ((l32 & 4) << 1) | ((l32 & 8) >> 1);
    u32x4 qreg[2], kreg[2], vreg[4];
    const unsigned qk_off = (unsigned)((tid >> 4) * 512 + (tid & 15) * 8) * 2u, v_off = (unsigned)((tid >> 3) * S_ + (tid & 7) * 8) * 2u;
#define GO_GLOAD(uu) do { const int h_ = (uu) & 3, bc_ = (uu) >> 2, b_ = bc_ >> 8, c_ = bc_ & 255; const long t0_ = (long)b_ * S_ + c_ * 64; \
    const char* qb_ = (const char*)(Q + t0_ * 512 + h_ * 128); const char* kb_ = (const char*)(K + t0_ * 512 + h_ * 128); \
    const char* vb_ = (const char*)(VT + ((long)(b_ * 1024 + h_ * 256)) * S_ + c_ * 64); \
    qreg[0] = *(const u32x4*)(qb_ + qk_off); qreg[1] = *(const u32x4*)(qb_ + 32768 + qk_off); \
    kreg[0] = *(const u32x4*)(kb_ + qk_off); kreg[1] = *(const u32x4*)(kb_ + 32768 + qk_off); \
    _Pragma("unroll") for (int i_ = 0; i_ < 4; ++i_) vreg[i_] = *(const u32x4*)(vb_ + (size_t)i_ * 64 * S_ * 2 + v_off); } while (0)
#define GO_LWRITE() do { \
    *(LAS u32x4*)(lds + (tid >> 4) * OQ_STR + (tid & 15) * 16) = qreg[0]; *(LAS u32x4*)(lds + (32 + (tid >> 4)) * OQ_STR + (tid & 15) * 16) = qreg[1]; \
    *(LAS u32x4*)(lds + OQ_BYTES + (tid >> 4) * OQ_STR + (tid & 15) * 16) = kreg[0]; *(LAS u32x4*)(lds + OQ_BYTES + (32 + (tid >> 4)) * OQ_STR + (tid & 15) * 16) = kreg[1]; \
    _Pragma("unroll") for (int i_ = 0; i_ < 4; ++i_) *(LAS u32x4*)(lds + 2 * OQ_BYTES + (i_ * 64 + (tid >> 3)) * OV_STR + (tid & 7) * 16) = vreg[i_]; } while (0)
    if ((int)blockIdx.x < 2048) { GO_GLOAD(blockIdx.x); GO_LWRITE(); }
    __syncthreads();
    for (int u = blockIdx.x; u < 2048; u += gridDim.x) {
        const int h = u & 3, bc = u >> 2, b = bc >> 8, c = bc & 255;
        const long tok0 = (long)b * S_ + c * 64;
        const bool has_next = u + (int)gridDim.x < 2048;
        if (has_next) GO_GLOAD(u + gridDim.x);
        bf16x8 qf[8];
        { LAS unsigned char* qp = lds + qi * OQ_STR + g * 16;
#pragma unroll
          for (int s = 0; s < 8; ++s) qf[s] = *(const LAS bf16x8*)(qp + 32 * s); }
        f32x16 sT[2] = {zero16(), zero16()};
#pragma unroll
        for (int hh = 0; hh < 2; ++hh) {
            if (hh <= qt) {
                LAS unsigned char* kp = lds + OQ_BYTES + (32 * hh + krow) * OQ_STR + g * 16;
#pragma unroll
                for (int s = 0; s < 8; ++s) { const bf16x8 a = *(const LAS bf16x8*)(kp + 32 * s); sT[hh] = MFMA32(a, qf[s], sT[hh]); }
#pragma unroll
                for (int i = 0; i < 16; ++i) { const int key = 32 * hh + 16 * (i >> 3) + 8 * g + (i & 7); if (key > qi) sT[hh][i] = 0.f; }
            }
        }
        bf16x8 pb[4] = {pack_lo(sT[0]), pack_hi(sT[0]), pack_lo(sT[1]), pack_hi(sT[1])};
        f32x16 o[2] = {zero16(), zero16()};
#pragma unroll
        for (int dvt = 0; dvt < 2; ++dvt) {
            LAS unsigned char* vp = lds + 2 * OQ_BYTES + (dq * 64 + dvt * 32 + l32) * OV_STR + g * 16;
#pragma unroll
            for (int ss = 0; ss < 4; ++ss) {
                const bf16x8 a8 = *(const LAS bf16x8*)(vp + 32 * ss);
                o[dvt] = MFMA32(a8, pb[ss], o[dvt]);
            }
        }
        { LAS float* op = OL + qi * 260 + dq * 64 + 4 * g;
#pragma unroll
          for (int dvt = 0; dvt < 2; ++dvt)
#pragma unroll
              for (int a = 0; a < 4; ++a) *(LAS f32x4*)(op + dvt * 32 + a * 8) = (f32x4){o[dvt][4 * a], o[dvt][4 * a + 1], o[dvt][4 * a + 2], o[dvt][4 * a + 3]}; }
        __syncthreads();
        if (has_next) GO_LWRITE();
#pragma unroll
        for (int k = 0; k < 4; ++k) {
            const int cidx = tid + 512 * k, row = cidx >> 5, col = (cidx & 31) * 8;
            const f32x4 oa = *(const LAS f32x4*)(OL + row * 260 + col), ob = *(const LAS f32x4*)(OL + row * 260 + col + 4);
            bf16_t* yrow = Y + (tok0 + row) * 1024 + h * 256 + col;
            const u32x4 yi = *(const u32x4*)yrow;
            float v[8] = {oa[0] + bflo(yi[0]), oa[1] + bfhi(yi[0]), oa[2] + bflo(yi[1]), oa[3] + bfhi(yi[1]),
                          ob[0] + bflo(yi[2]), ob[1] + bfhi(yi[2]), ob[2] + bflo(yi[3]), ob[3] + bfhi(yi[3])};
            float sum = 0.f, ssq = 0.f;
#pragma unroll
            for (int e = 0; e < 8; ++e) { sum += v[e]; ssq += v[e] * v[e]; }
#pragma unroll
            for (int sh = 1; sh < 32; sh <<= 1) { sum += shx(sum, sh, lane); ssq += shx(ssq, sh, lane); }
            const float mu = sum * (1.f / 256.f), var = fmaxf(ssq * (1.f / 256.f) - mu * mu, 0.f), rstd = 1.0f / sqrtf(var + 1e-5f);
            const u32x4 ri = *(const u32x4*)(R + (tok0 + row) * 1024 + h * 256 + col);
            const f32x4 ga = *(const f32x4*)(ng + h * 256 + col), gb = *(const f32x4*)(ng + h * 256 + col + 4);
            const float rv[8] = {bflo(ri[0]), bfhi(ri[0]), bflo(ri[1]), bfhi(ri[1]), bflo(ri[2]), bfhi(ri[2]), bflo(ri[3]), bfhi(ri[3])};
            float yv[8];
#pragma unroll
            for (int e = 0; e < 8; ++e) { const float r = rv[e], gg = e < 4 ? ga[e & 3] : gb[e & 3]; yv[e] = r * __builtin_amdgcn_rcpf(1.f + __expf(-r)) * ((v[e] - mu) * rstd * gg); }
            *(u32x4*)yrow = (u32x4){pk2(yv[0], yv[1]), pk2(yv[2], yv[3]), pk2(yv[4], yv[5]), pk2(yv[6], yv[7])};
        }
        __syncthreads();
    }
#undef GO_GLOAD
#undef GO_LWRITE
}

#define XB_TMO      128
#define XB_XCNT(j)  (256  + 64 * (j))
#define XB_XSUB(j)  (1280 + 64 * (j))
#define XB_XGEN(j)  (2304 + 64 * (j))
#define XB_TOP      3328
#define XB_TOPGEN   3392
#define XCD_BAR_WORDS 3456
#define XB_SPIN_CAP (1u << 22)
DI unsigned xb_ld(unsigned* p) { return __hip_atomic_load(p, __ATOMIC_RELAXED, __HIP_MEMORY_SCOPE_AGENT); }
DI unsigned xb_add(unsigned* p, unsigned v) { return __hip_atomic_fetch_add(p, v, __ATOMIC_RELAXED, __HIP_MEMORY_SCOPE_AGENT); }
DI unsigned xb_xcc_id() { return (unsigned)__builtin_amdgcn_s_getreg((3 << 11) | 20) & 0xFu; }
#define XB_SPIN(cond, bar) do { unsigned _sp = 0; while (cond) {   \
    if ((++_sp & 255u) == 0u) { if (xb_ld(&(bar)[XB_TMO])) break; if (_sp > XB_SPIN_CAP) { atomicAdd(&(bar)[XB_TMO], 1u); break; } } } } while (0)
DI void xcd_barrier_complete(unsigned* bar, unsigned x, unsigned& nloc, unsigned& nx) {
    const unsigned G = gridDim.x;
    unsigned sum, cnt, mine, sp = 0u;
    for (;;) {
        sum = 0u; cnt = 0u; mine = 0u;
#pragma unroll
        for (unsigned j = 0; j < 16; ++j) { const unsigned c = xb_ld(&bar[XB_XCNT(j)]); sum += c; cnt += (c > 0u) ? 1u : 0u; mine = (j == x) ? c : mine; }
        if (sum == G) break;
        __builtin_amdgcn_s_sleep(1);
        if ((++sp & 255u) == 0u) { if (xb_ld(&bar[XB_TMO])) break; if (sp > XB_SPIN_CAP) { atomicAdd(&bar[XB_TMO], 1u); break; } }
    }
    nloc = mine > 0u ? mine : 1u; nx = cnt > 0u ? cnt : 1u;
}
DI void grid_bar(unsigned* bar) {
    volatile LAS unsigned* st = (volatile LAS unsigned*)((LAS unsigned char*)smem + LDS_BYTES);
    asm volatile("s_waitcnt vmcnt(0)" ::: "memory");
    __syncthreads();
    if (threadIdx.x == 0) {
        __builtin_amdgcn_s_waitcnt(0);
        const unsigned x = xb_xcc_id();
        unsigned nloc = st[0], nx = st[1];
        if (nloc == 0u) { xcd_barrier_complete(bar, x, nloc, nx); st[0] = nloc; st[1] = nx; }
        const unsigned old = xb_add(&bar[XB_XSUB(x)], 1u);
        const unsigned gen = old / nloc;
        if (old + 1u == (gen + 1u) * nloc) {
            __builtin_amdgcn_fence(__ATOMIC_RELEASE, "agent");
            asm volatile("s_waitcnt vmcnt(0)" ::: "memory");
            const unsigned og = xb_add(&bar[XB_TOP], 1u);
            const unsigned tg = og / nx;
            if (og + 1u == (tg + 1u) * nx) xb_add(&bar[XB_TOPGEN], 1u);
            else XB_SPIN(xb_ld(&bar[XB_TOPGEN]) == tg, bar);
            __builtin_amdgcn_fence(__ATOMIC_ACQUIRE, "agent");
            xb_add(&bar[XB_XGEN(x)], 1u);
            asm volatile("s_waitcnt vmcnt(0)" ::: "memory");
        } else {
            XB_SPIN(xb_ld(&bar[XB_XGEN(x)]) == gen, bar);
            __builtin_amdgcn_fence(__ATOMIC_ACQUIRE, "agent");
            asm volatile("s_waitcnt vmcnt(0)" ::: "memory");
        }
    }
    __syncthreads();
}
#ifndef PHM
#define PHM 0xFFFF
#endif
#define PH(k) ((PHM >> (k)) & 1)
__global__ void __launch_bounds__(NTHR) fwd_kernel(Params p) {
    cg::grid_group grid = cg::this_grid();
    const int wv = __builtin_amdgcn_readfirstlane((int)threadIdx.x >> 6);
    unsigned* bar = (unsigned*)wsptr(p);
    { volatile LAS unsigned* st = (volatile LAS unsigned*)((LAS unsigned char*)smem + LDS_BYTES);
      if (threadIdx.x == 0) { st[0] = 0u; st[1] = 0u; (void)xb_add(&bar[XB_XCNT(xb_xcc_id())], 1u); } __syncthreads(); }
#define W ((const bf16_t*)(wsptr(p) + OFF_W))
#define HB ((bf16_t*)(wsptr(p) + OFF_HB))
#define Y ((bf16_t*)(wsptr(p) + OFF_Y))
#define Pb ((bf16_t*)(wsptr(p) + OFF_P))
#define H (outptr(p))
#define STATP ((float*)(wsptr(p) + OFF_STAT))
#define LNG(i) (inptr(p, 17) + (long)(i) * 1024)
#define LNB(i) (inptr(p, 18) + (long)(i) * 1024)
#define LNXP(i) ((unsigned long long*)(wsptr(p) + OFF_LNX) + (long)(i) * 131072)
#define LNCP(i) ((unsigned*)(wsptr(p) + OFF_LNC) + (i) * 2048)

    if (PH(0)) phase_convert(p, wv);
    if (p.conv_tiles < 0) grid.sync();
    grid_bar((unsigned*)wsptr(p));
#pragma unroll 1
    for (int layer = 0; layer < 4; ++layer) {
        const int mix = layer % 3, j = layer / 3;
        if (mix == 0) {
            if (PH(1)) { EpiGlaIn e{Pb, (float*)(wsptr(p) + OFF_P + GP_GL)}; gemm_phase(wv, HB, 1024, W + p.w_gla_in[j], 1024, T_, 3328, 1024, e); }
            grid_bar((unsigned*)wsptr(p));
            if (PH(2)) phase_gla_prep(p, wv, j);
            grid_bar((unsigned*)wsptr(p));
            if (PH(3)) phase_gla_scan<false>(p, wv);
            grid_bar((unsigned*)wsptr(p));
            if (PH(3)) phase_gla_combine(p, wv);
            grid_bar((unsigned*)wsptr(p));
            if (PH(3)) phase_gla_scan<true>(p, wv);
            grid_bar((unsigned*)wsptr(p));
            if (PH(4)) phase_gla_out(p, wv, j);
            grid_bar((unsigned*)wsptr(p));
            if (PH(5)) { EpiResLN e{(layer == 0) ? inptr(p, 0) : H, H, HB, LNG(layer * 2), LNB(layer * 2), LNXP(layer * 2), LNCP(layer * 2)}; gemm_phase(wv, Y, 1024, W + p.w_gla_out[j], 1024, T_, 1024, 1024, e); }
        } else if (mix == 1) {
            if (PH(6)) { EpiRpaIn e{Pb, 0.125f * LOG2E}; gemm_phase(wv, HB, 1024, W + p.w_rpa_in, 1024, T_, 3072, 1024, e); }
            grid_bar((unsigned*)wsptr(p));
            if (PH(7)) phase_rpa_attn(p, wv);
            grid_bar((unsigned*)wsptr(p));
            if (PH(5)) { EpiResLN e{(layer == 0) ? inptr(p, 0) : H, H, HB, LNG(layer * 2), LNB(layer * 2), LNXP(layer * 2), LNCP(layer * 2)}; gemm_phase(wv, Y, 1024, W + p.w_rpa_out, 1024, T_, 1024, 1024, e); }
        } else {
            if (PH(8)) { EpiPlain e{Y, 768, 1.f}; gemm_phase(wv, HB, 1024, W + p.w_mla_in, 1024, T_, 768, 1024, e); }
            grid_bar((unsigned*)wsptr(p));
            if (PH(9)) phase_mla_norm(p, wv);
            grid_bar((unsigned*)wsptr(p));
            if (PH(8)) { EpiPlain e{Pb + MP_Q / 2, 1536, 0.07216878364870322f * LOG2E}; gemm_phase(wv, Y, 768, W + p.w_mla_uq, 384, T_, 1536, 384, e); }
            if (PH(10)) { EpiMlaKv e{Pb + MP_KN / 2, Pb + MP_VT / 2}; gemm_phase(wv, Y + 384, 768, W + p.w_mla_ukv, 256, T_, 2048, 256, e); }
            grid_bar((unsigned*)wsptr(p));
            if (PH(11)) phase_mla_attn(p, wv);
            grid_bar((unsigned*)wsptr(p));
            if (PH(5)) { EpiResLN e{(layer == 0) ? inptr(p, 0) : H, H, HB, LNG(layer * 2), LNB(layer * 2), LNXP(layer * 2), LNCP(layer * 2)}; gemm_phase(wv, Y, 1024, W + p.w_mla_out, 1024, T_, 1024, 1024, e); }
        }
        grid_bar((unsigned*)wsptr(p));
        if (PH(13)) { EpiSwiglu e{Pb}; gemm_phase(wv, HB, 1024, W + p.w_ffn_in[layer], 1024, T_, 2 * FFH, 1024, e); }
        grid_bar((unsigned*)wsptr(p));
        if (PH(5)) { EpiResLN e{H, H, HB, LNG(layer * 2 + 1), LNB(layer * 2 + 1), LNXP(layer * 2 + 1), LNCP(layer * 2 + 1)}; gemm_phase(wv, Pb, FFH, W + p.w_ffn_out[layer], FFH, T_, 1024, FFH, e); }
        grid_bar((unsigned*)wsptr(p));
    }
}

#undef W
#undef HB
#undef Y
#undef Pb
#undef H
#undef STATP
#undef LNG
#undef LNB
#undef LNXP
#undef LNCP
extern "C" void kernel_launch(void* const* d_in, const int* in_sizes, int n_in, void* d_out, int out_size, void* d_ws, size_t ws_size, hipStream_t stream) {
    static int grid_blocks = 0;
    if (!grid_blocks) {
        int dev = 0, cus = 0, per_cu = 0;
        hipGetDevice(&dev);
        hipDeviceGetAttribute(&cus, hipDeviceAttributeMultiprocessorCount, dev);
        hipFuncSetAttribute((const void*)fwd_kernel, hipFuncAttributeMaxDynamicSharedMemorySize, LDS_BYTES + 64);
        hipOccupancyMaxActiveBlocksPerMultiprocessor(&per_cu, (const void*)fwd_kernel, NTHR, LDS_BYTES + 64);
        if (per_cu < 1) per_cu = 1;
        grid_blocks = cus * per_cu;
        if (ws_size < 472 * MiB) fprintf(stderr, "kernel_launch: workspace too small: %zu\n", ws_size);
    }
    Params p; memset(&p, 0, sizeof(p));
    for (int i = 0; i < 19; ++i) p.in[i] = (const float*)d_in[i];
    p.out = (float*)d_out; p.ws = (unsigned char*)d_ws;
    long woff = 0; int nd = 0, tiles = 0;
    auto add = [&](int idx, long src_off, int K, int Nsrc, int Npad, int perm) -> long {
        ConvDesc& c = p.cd[nd++]; c.in_idx = idx; c.K = K; c.Nsrc = Nsrc; c.Npad = Npad; c.perm = perm; c.tile0 = tiles; c.src_off = src_off; c.dst_off = woff;
        tiles += (K / 64) * (Npad / 64); const long o = woff; woff += (long)K * Npad; return o;
    };
    for (int j = 0; j < 2; ++j) { p.w_gla_in[j] = add(1, (long)j * 1024 * 3088, 1024, 3088, 3328, 0); p.w_gla_out[j] = add(5, (long)j * 1024 * 1024, 1024, 1024, 1024, 0); }
    p.w_rpa_in = add(6, 0, 1024, 3072, 3072, 0); p.w_rpa_out = add(8, 0, 1024, 1024, 1024, 0);
    p.w_mla_in = add(9, 0, 1024, 704, 768, 0); p.w_mla_uq = add(12, 0, 384, 1536, 1536, 0); p.w_mla_ukv = add(13, 0, 256, 2048, 2048, 0); p.w_mla_out = add(14, 0, 1024, 1024, 1024, 0);
    for (int l = 0; l < 4; ++l) { p.w_ffn_in[l] = add(15, (long)l * 1024 * 5632, 1024, 5632, 5632, 1); p.w_ffn_out[l] = add(16, (long)l * FFH * 1024, FFH, 1024, 1024, 0); }
    p.ncd = nd; p.conv_tiles = tiles;
    hipMemsetAsync(d_ws, 0, 131072, stream);
    void* args[] = {&p};
    hipError_t e = hipLaunchCooperativeKernel((const void*)fwd_kernel, dim3(grid_blocks), dim3(NTHR), args, LDS_BYTES + 64, stream);
    if (e != hipSuccess) fprintf(stderr, "cooperative launch failed: %s (grid %d)\n", hipGetErrorString(e), grid_blocks);
}
```

```cpp
#include <hip/hip_runtime.h>
#include <hip/hip_cooperative_groups.h>
#include <cstdint>
#include <cstdio>
#include <cstring>
namespace cg = cooperative_groups;

#define LAS __attribute__((address_space(3)))
#define DI __device__ __forceinline__
typedef unsigned short bf16_t;
typedef short bf16x8 __attribute__((ext_vector_type(8)));
typedef float f32x4 __attribute__((ext_vector_type(4)));
typedef float f32x2 __attribute__((ext_vector_type(2)));
typedef float f32x16 __attribute__((ext_vector_type(16)));
typedef unsigned u32x4 __attribute__((ext_vector_type(4)));
typedef unsigned u32x2 __attribute__((ext_vector_type(2)));
typedef __bf16 bfx2 __attribute__((ext_vector_type(2)));

constexpr int T_ = 32768, S_ = 16384, NCH = 256;
constexpr int FFH = 2816;
constexpr float ALPHA = 1.6817928305074290f;
constexpr float LOG2E = 1.4426950408889634f;
constexpr int NTHR = 512;
constexpr int LDS_BYTES = 155648;

constexpr size_t MiB = 1024 * 1024;
constexpr size_t OFF_COS = 1 * MiB, OFF_SIN = 3 * MiB, OFF_DECAY = 5 * MiB, OFF_STAT = 6 * MiB, OFF_W = 8 * MiB;
constexpr size_t OFF_HB = 106 * MiB, OFF_Y = 170 * MiB, OFF_P = 234 * MiB;
constexpr size_t GP_Q = 0, GP_K = 32 * MiB, GP_KT = 64 * MiB, GP_VT = 96 * MiB, GP_R = 160 * MiB, GP_GL = 224 * MiB;
constexpr size_t RP_Q = 0, RP_K = 64 * MiB, RP_VT = 128 * MiB;
constexpr size_t MP_Q = 0, MP_KN = 96 * MiB, MP_VT = 160 * MiB, MP_KR = 224 * MiB;

struct ConvDesc { int in_idx, K, Nsrc, Npad, perm, tile0; long src_off, dst_off; };
struct Params {
    const float* in[19]; float* out; unsigned char* ws;
    ConvDesc cd[18]; int ncd, conv_tiles;
    long w_gla_in[2], w_gla_out[2], w_rpa_in, w_rpa_out, w_mla_in, w_mla_uq, w_mla_ukv, w_mla_out, w_ffn_in[4], w_ffn_out[4];
};

extern __shared__ __attribute__((aligned(16))) unsigned char smem[];

DI unsigned pk2(float lo, float hi) { f32x2 v = {lo, hi}; bfx2 b = __builtin_convertvector(v, bfx2); return __builtin_bit_cast(unsigned, b); }
DI bf16_t f2bf(float x) { return (bf16_t)(pk2(x, 0.f) & 0xffffu); }
DI float bf2f(unsigned v) { return __uint_as_float(v << 16); }
DI float bflo(unsigned u) { return __uint_as_float(u << 16); }
DI float bfhi(unsigned u) { return __uint_as_float(u & 0xffff0000u); }
DI bf16x8 pack8(float a0, float a1, float a2, float a3, float a4, float a5, float a6, float a7) {
    u32x4 p = {pk2(a0, a1), pk2(a2, a3), pk2(a4, a5), pk2(a6, a7)}; return __builtin_bit_cast(bf16x8, p);
}
#define MFMA32(a, b, c) __builtin_amdgcn_mfma_f32_32x32x16_bf16((a), (b), (c), 0, 0, 0)
DI f32x16 zero16() { f32x16 z; for (int i = 0; i < 16; ++i) z[i] = 0.f; return z; }
DI bf16x8 pack_lo(const f32x16& x) { return pack8(x[0], x[1], x[2], x[3], x[4], x[5], x[6], x[7]); }
DI bf16x8 pack_hi(const f32x16& x) { return pack8(x[8], x[9], x[10], x[11], x[12], x[13], x[14], x[15]); }
DI int phase_tid(int wv) { int z = 0; asm volatile("" : "+s"(wv), "+s"(z)); const int lane = __builtin_amdgcn_mbcnt_hi(~0u, __builtin_amdgcn_mbcnt_lo(~0u, z)); return wv * 64 + lane; }
DI float shx(float v, int m, int lane) { return __int_as_float(__builtin_amdgcn_ds_bpermute((lane ^ m) << 2, __float_as_int(v))); }
DI float xh_max(float v) { const auto r = __builtin_amdgcn_permlane32_swap(__float_as_uint(v), __float_as_uint(v), false, false); return fmaxf(__uint_as_float(r[0]), __uint_as_float(r[1])); }
DI float xh_sum(float v) { const auto r = __builtin_amdgcn_permlane32_swap(__float_as_uint(v), __float_as_uint(v), false, false); return __uint_as_float(r[0]) + __uint_as_float(r[1]); }
DI unsigned char* wsptr(const Params& p) { int z = 0; asm volatile("" : "+s"(z)); return p.ws + z; }
DI float* outptr(const Params& p) { int z = 0; asm volatile("" : "+s"(z)); return p.out + z; }
DI const float* inptr(const Params& p, int i) { asm volatile("" : "+s"(i)); return p.in[i]; }
DI int vcu_of_block() { const int G = gridDim.x, bx = blockIdx.x; return (G % 8 == 0) ? (bx % 8) * (G / 8) + bx / 8 : bx; }

constexpr int BM = 256, BK = 64, HALF = 128, NXCD = 8, WGM = 8, HT = HALF * BK;
DI int lds_byte(int r, int c) { int st = (r >> 4) * 2 + (c >> 5), rr = r & 15, cc = c & 31, ob = rr * 64 + cc * 2; return st * 1024 + (ob ^ (((ob >> 9) & 1) << 5)); }
DI void stage_rc(int b, int& R, int& C) { int st = b / 1024, sb = b % 1024, swz = sb ^ (((sb >> 9) & 1) << 5); R = (st >> 1) * 16 + swz / 64; C = (st & 1) * 32 + (swz % 64) / 2; }

typedef f32x4 AccT[2][2][4][2];

template <class Epi>
DI void gemm_phase(int wv, const bf16_t* __restrict__ A, int lda, const bf16_t* __restrict__ Bt, int ldb, int M, int N, int K, const Epi& epi) {
    LAS unsigned char* lds = (LAS unsigned char*)smem;
    const int tid_ = phase_tid(wv); const int tid = tid_, wid = __builtin_amdgcn_readfirstlane(tid >> 6), lane = tid & 63, wr = wid >> 2, wc = wid & 3, fr = lane & 15, fq = lane >> 4;
    unsigned voffA[2], voffB[2];
#pragma unroll
    for (int i = 0; i < 2; ++i) { int R, C; stage_rc(tid * 16 + i * 8192, R, C); voffA[i] = (unsigned)(R * lda + C) * 2u; voffB[i] = (unsigned)(R * ldb + C) * 2u; }
    const size_t kstep = (size_t)(BK * 2), hstepA = (size_t)HALF * lda * 2, hstepB = (size_t)HALF * ldb * 2;
    const unsigned ldsw = (unsigned)wid * 1024u;
    const int aoff = lds_byte(wr * 64 + fr, fq * 8), boff = lds_byte(wc * 32 + fr, fq * 8);
    constexpr int HTB = HT * 2;
#define SA(b, h) (((b) * 2 + (h)) * HTB)
#define SB(b, h) ((4 + (b) * 2 + (h)) * HTB)
#define STAGE(bufoff, gbase, voff) do { _Pragma("unroll") for (int _i = 0; _i < 2; ++_i) \
    __builtin_amdgcn_global_load_lds((const unsigned*)((const char*)(gbase) + (voff)[_i]), (LAS unsigned*)(lds + (bufoff) + ldsw + _i * 8192), 16, 0, 0); } while (0)
#define LDA(dst, b, h) do { _Pragma("unroll") for (int m = 0; m < 4; ++m) _Pragma("unroll") for (int k = 0; k < 2; ++k) dst[m][k] = *(const LAS bf16x8*)(lds + SA(b, h) + aoff + m * 2048 + k * 1024); } while (0)
#define LDB(dst, b, h) do { _Pragma("unroll") for (int n = 0; n < 2; ++n) _Pragma("unroll") for (int k = 0; k < 2; ++k) dst[n][k] = *(const LAS bf16x8*)(lds + SB(b, h) + boff + n * 2048 + k * 1024); } while (0)
#define MMA(ai, bj, At_, Bt_) do { __builtin_amdgcn_s_setprio(1); _Pragma("unroll") for (int m = 0; m < 4; ++m) _Pragma("unroll") for (int n = 0; n < 2; ++n) _Pragma("unroll") for (int k = 0; k < 2; ++k) \
      acc[ai][bj][m][n] = __builtin_amdgcn_mfma_f32_16x16x32_bf16(Bt_[n][k], At_[m][k], acc[ai][bj][m][n], 0, 0, 0); \
    __builtin_amdgcn_s_setprio(0); } while (0)
#define WAIT_V(n) asm volatile("s_waitcnt vmcnt(" #n ")" ::: "memory")
#define WAIT_L(n) asm volatile("s_waitcnt lgkmcnt(" #n ")" ::: "memory")
#define BAR __builtin_amdgcn_s_barrier()
#define SCHED __builtin_amdgcn_sched_barrier(0)
    const int nM = M / BM, nN = N / BM, nwg = nM * nN, nt = K / BK;
#define UNIT_COORDS(uu, BR, BC) do { int wgid = (uu); \
        { int q = nwg / NXCD, r = nwg % NXCD, xcd = wgid % NXCD, off = wgid / NXCD; wgid = (xcd < r ? xcd * (q + 1) : r * (q + 1) + (xcd - r) * q) + off; } \
        const int nig = WGM * nN, gid = wgid / nig, fm = gid * WGM, gsz = min(nM - fm, WGM); \
        BR = (fm + ((wgid % nig) % gsz)) * BM; BC = ((wgid % nig) / gsz) * BM; } while (0)
    if ((int)blockIdx.x < nwg) {
        int brow, bcol; UNIT_COORDS(blockIdx.x, brow, bcol);
        const char* cA = (const char*)A + (size_t)brow * lda * 2; const char* cB = (const char*)Bt + (size_t)bcol * ldb * 2;
        AccT acc;
#pragma unroll
        for (int a = 0; a < 2; ++a)
#pragma unroll
            for (int b = 0; b < 2; ++b)
#pragma unroll
                for (int m = 0; m < 4; ++m)
#pragma unroll
                    for (int n = 0; n < 2; ++n) acc[a][b][m][n] = (f32x4){0.f, 0.f, 0.f, 0.f};
        bf16x8 At[4][2], B0[2][2], B1[2][2];
        STAGE(SB(0, 0), cB, voffB); STAGE(SB(0, 1), cB + hstepB, voffB); STAGE(SA(0, 0), cA, voffA); STAGE(SA(0, 1), cA + hstepA, voffA);
        if (wr == 1) BAR;
        WAIT_V(2); BAR;
        STAGE(SB(1, 0), cB + kstep, voffB); STAGE(SA(1, 0), cA + kstep, voffA); STAGE(SB(1, 1), cB + hstepB + kstep, voffB);
        WAIT_V(6); BAR;
        for (int u = blockIdx.x;;) {
            const bool has_next = u + (int)gridDim.x < nwg;
            int nbrow = brow, nbcol = bcol;
            if (has_next) UNIT_COORDS(u + gridDim.x, nbrow, nbcol);
            const char* nA = (const char*)A + (size_t)nbrow * lda * 2; const char* nB = (const char*)Bt + (size_t)nbcol * ldb * 2;
#pragma unroll 1
            for (int t = 0; t < nt; t += 2) {
                const bool last = (t == nt - 2);
                const char* a1 = cA + (size_t)(t + 1) * kstep;
                const char* a2 = last ? nA : cA + (size_t)(t + 2) * kstep; const char* b2 = last ? nB : cB + (size_t)(t + 2) * kstep;
                const char* a3 = a2 + kstep; const char* b3 = b2 + kstep;
                LDB(B0, 0, 0); LDB(B1, 0, 1); SCHED; LDA(At, 0, 0); STAGE(SA(1, 1), a1 + hstepA, voffA);
                WAIT_V(8); WAIT_L(0); BAR; MMA(0, 0, At, B0); MMA(0, 1, At, B1); BAR; SCHED;
                LDA(At, 0, 1); STAGE(SB(0, 0), b2, voffB); STAGE(SB(0, 1), b2 + hstepB, voffB); STAGE(SA(0, 0), a2, voffA);
                WAIT_V(8); WAIT_L(0); BAR; MMA(1, 0, At, B0); MMA(1, 1, At, B1); BAR; SCHED;
                LDB(B0, 1, 0); LDB(B1, 1, 1); SCHED; LDA(At, 1, 0); STAGE(SA(0, 1), a2 + hstepA, voffA);
                WAIT_V(8); WAIT_L(0); BAR; MMA(0, 0, At, B0); MMA(0, 1, At, B1); BAR; SCHED;
                LDA(At, 1, 1); STAGE(SB(1, 0), b3, voffB); STAGE(SB(1, 1), b3 + hstepB, voffB); STAGE(SA(1, 0), a3, voffA);
                WAIT_V(8); WAIT_L(0); BAR; MMA(1, 0, At, B0); MMA(1, 1, At, B1); BAR; SCHED;
            }
            if (wr == 0) BAR;
            epi(acc, brow, bcol, wr, wc, fr, fq);
            if (!has_next) break;
#pragma unroll
            for (int a = 0; a < 2; ++a)
#pragma unroll
                for (int b = 0; b < 2; ++b)
#pragma unroll
                    for (int m = 0; m < 4; ++m)
#pragma unroll
                        for (int n = 0; n < 2; ++n) acc[a][b][m][n] = (f32x4){0.f, 0.f, 0.f, 0.f};
            brow = nbrow; bcol = nbcol; cA = nA; cB = nB; u += gridDim.x;
            if (wr == 1) BAR;
        }
        WAIT_V(0);
    }
    __syncthreads();
#undef UNIT_COORDS
}

DI void st_rm_half(const AccT& acc, int bj, bf16_t* O, int ld, int brow, int colbase, float sc, int wr, int wc, int fr, int fq) {
#pragma unroll
    for (int ai = 0; ai < 2; ++ai)
#pragma unroll
        for (int m = 0; m < 4; ++m) {
            const int row = brow + ai * 128 + wr * 64 + m * 16 + fr;
            { const f32x4 v0 = acc[ai][bj][m][0] * sc, v1 = acc[ai][bj][m][1] * sc;
              u32x4 w = {pk2(v0[0], v0[1]), pk2(v0[2], v0[3]), pk2(v1[0], v1[1]), pk2(v1[2], v1[3])};
              *(u32x4*)(O + (long)row * ld + colbase + wc * 32 + fq * 8) = w; }
            asm volatile("" ::: "memory");
        }
}
DI void st_tr_half(const AccT& acc, int bj, bf16_t* VT, int brow, int vcolbase, int wr, int wc, int fr, int fq) {
    const int b = brow / S_, s0 = brow % S_;
#pragma unroll
    for (int ai = 0; ai < 2; ++ai)
#pragma unroll
        for (int m = 0; m < 4; ++m) {
            const int s = s0 + ai * 128 + wr * 64 + m * 16 + fr;
#pragma unroll
            for (int n = 0; n < 2; ++n) {
                const f32x4 v = acc[ai][bj][m][n];
                const int vc = vcolbase + wc * 32 + fq * 8 + n * 4;
                bf16_t* pp = VT + ((long)(b * 1024 + vc)) * S_ + s;
                pp[0] = f2bf(v[0]); pp[(long)S_] = f2bf(v[1]); pp[2L * S_] = f2bf(v[2]); pp[3L * S_] = f2bf(v[3]);
            }
            asm volatile("" ::: "memory");
        }
}

struct EpiGlaIn { bf16_t* Pb; float* GL;
    DI void operator()(const AccT& acc, int brow, int bcol, int wr, int wc, int fr, int fq) const {
        const int pn = bcol >> 8;
        if (pn >= 4 && pn < 8) {
            bf16_t* VT = Pb + GP_VT / 2;
            st_tr_half(acc, 0, VT, brow, bcol - 1024, wr, wc, fr, fq); st_tr_half(acc, 1, VT, brow, bcol - 1024 + 128, wr, wc, fr, fq);
        } else if (pn == 12) {
            if (wc == 0) {
#pragma unroll
                for (int ai = 0; ai < 2; ++ai)
#pragma unroll
                    for (int m = 0; m < 4; ++m) { const int row = brow + ai * 128 + wr * 64 + m * 16 + fr; if (fq < 2) { *(f32x4*)(GL + (long)row * 16 + fq * 8) = acc[ai][0][m][0]; *(f32x4*)(GL + (long)row * 16 + fq * 8 + 4) = acc[ai][0][m][1]; } }
            }
        } else {
            bf16_t* O = Pb + (pn < 2 ? GP_Q / 2 : (pn < 4 ? GP_K / 2 : GP_R / 2));
            const int ld = pn < 4 ? 512 : 1024, cb = pn < 2 ? bcol : (pn < 4 ? bcol - 512 : bcol - 2048);
            st_rm_half(acc, 0, O, ld, brow, cb, 1.f, wr, wc, fr, fq); st_rm_half(acc, 1, O, ld, brow, cb + 128, 1.f, wr, wc, fr, fq);
        }
    }
};
struct EpiRpaIn { bf16_t* Pb; float qscale;
    DI void operator()(const AccT& acc, int brow, int bcol, int wr, int wc, int fr, int fq) const {
        const int pn = bcol >> 8;
        bf16_t* Q = Pb + RP_Q / 2; bf16_t* K = Pb + RP_K / 2; bf16_t* VT = Pb + RP_VT / 2;
        if (pn < 8) { bf16_t* O = pn < 4 ? Q : K; const float sc = pn < 4 ? qscale : 1.f; const int cb = pn < 4 ? bcol : bcol - 1024;
            st_rm_half(acc, 0, O, 1024, brow, cb, sc, wr, wc, fr, fq); st_rm_half(acc, 1, O, 1024, brow, cb + 128, sc, wr, wc, fr, fq); }
        else { st_tr_half(acc, 0, VT, brow, bcol - 2048, wr, wc, fr, fq); st_tr_half(acc, 1, VT, brow, bcol - 2048 + 128, wr, wc, fr, fq); }
    }
};
struct EpiPlain { bf16_t* O; int ld; float sc;
    DI void operator()(const AccT& acc, int brow, int bcol, int wr, int wc, int fr, int fq) const {
        st_rm_half(acc, 0, O, ld, brow, bcol, sc, wr, wc, fr, fq); st_rm_half(acc, 1, O, ld, brow, bcol + 128, sc, wr, wc, fr, fq);
    }
};
struct EpiMlaKv { bf16_t* KN; bf16_t* VT;
    DI void operator()(const AccT& acc, int brow, int bcol, int wr, int wc, int fr, int fq) const {
        const int h = bcol >> 8;
        st_rm_half(acc, 0, KN, 1024, brow, h * 128, 1.f, wr, wc, fr, fq);
        st_tr_half(acc, 1, VT, brow, h * 128, wr, wc, fr, fq);
    }
};
struct EpiSwiglu { bf16_t* Hd;
    DI void operator()(const AccT& acc, int brow, int bcol, int wr, int wc, int fr, int fq) const {
        const int pn = bcol >> 8;
#pragma unroll
        for (int ai = 0; ai < 2; ++ai)
#pragma unroll
            for (int m = 0; m < 4; ++m) {
                const int row = brow + ai * 128 + wr * 64 + m * 16 + fr;
                unsigned wq[4];
#pragma unroll
                for (int n = 0; n < 2; ++n) {
                    const f32x4 gt = acc[ai][0][m][n], up = acc[ai][1][m][n];
                    const f32x4 ex = gt * (-LOG2E);
                    f32x4 dn; dn[0] = __builtin_amdgcn_exp2f(ex[0]); dn[1] = __builtin_amdgcn_exp2f(ex[1]); dn[2] = __builtin_amdgcn_exp2f(ex[2]); dn[3] = __builtin_amdgcn_exp2f(ex[3]);
                    dn = dn + 1.0f;
                    f32x4 rc; rc[0] = __builtin_amdgcn_rcpf(dn[0]); rc[1] = __builtin_amdgcn_rcpf(dn[1]); rc[2] = __builtin_amdgcn_rcpf(dn[2]); rc[3] = __builtin_amdgcn_rcpf(dn[3]);
                    const f32x4 o = (gt * up) * rc;
                    wq[2 * n] = pk2(o[0], o[1]); wq[2 * n + 1] = pk2(o[2], o[3]);
                }
                *(u32x4*)(Hd + (long)row * FFH + pn * 128 + wc * 32 + fq * 8) = (u32x4){wq[0], wq[1], wq[2], wq[3]};
                asm volatile("" ::: "memory");
            }
    }
};
struct EpiRes { const float* hs; float* out; const float* stat; const float* g; const float* b;
    DI void operator()(const AccT& acc, int brow, int bcol, int wr, int wc, int fr, int fq) const {
        const bool norm = stat != nullptr;
        f32x4 gv[2][2], bv[2][2];
#pragma unroll
        for (int bj = 0; bj < 2; ++bj)
#pragma unroll
            for (int n = 0; n < 2; ++n) {
                const int col = bcol + bj * 128 + wc * 32 + fq * 8 + n * 4;
                gv[bj][n] = norm ? *(const f32x4*)(g + col) : (f32x4){1.f, 1.f, 1.f, 1.f};
                bv[bj][n] = norm ? *(const f32x4*)(b + col) : (f32x4){0.f, 0.f, 0.f, 0.f};
            }
#pragma unroll
        for (int ai = 0; ai < 2; ++ai) {
#pragma unroll
            for (int mh = 0; mh < 2; ++mh) {
                f32x4 hv[2][2][2]; f32x2 sv[2];
#pragma unroll
                for (int mm = 0; mm < 2; ++mm) {
                    const int m = mh * 2 + mm;
                    const int row = brow + ai * 128 + wr * 64 + m * 16 + fr;
                    sv[mm] = norm ? *(const f32x2*)(stat + (long)row * 2) : (f32x2){0.f, 1.f};
#pragma unroll
                    for (int bj = 0; bj < 2; ++bj)
#pragma unroll
                        for (int n = 0; n < 2; ++n) hv[mm][bj][n] = *(const f32x4*)(hs + (long)row * 1024 + bcol + bj * 128 + wc * 32 + fq * 8 + n * 4);
                }
#pragma unroll
                for (int mm = 0; mm < 2; ++mm) {
                    const int m = mh * 2 + mm;
                    const int row = brow + ai * 128 + wr * 64 + m * 16 + fr;
                    const float ra = sv[mm][1], rc = -sv[mm][0] * sv[mm][1];
#pragma unroll
                    for (int bj = 0; bj < 2; ++bj)
#pragma unroll
                        for (int n = 0; n < 2; ++n) {
                            const f32x4 hn = (hv[mm][bj][n] * ra + rc) * gv[bj][n] + bv[bj][n];
                            *(f32x4*)(out + (long)row * 1024 + bcol + bj * 128 + wc * 32 + fq * 8 + n * 4) = hn * ALPHA + acc[ai][bj][m][n];
                        }
                }
                asm volatile("" ::: "memory");
            }
        }
    }
};

constexpr size_t OFF_LNX = 464 * MiB;
constexpr size_t OFF_LNC = 32768;
struct EpiResLN { static constexpr int NVM = 0;
    const float* hs; float* outh; bf16_t* outb; const float* g; const float* b; unsigned long long* xbuf; unsigned* cnt;
    DI void operator()(const AccT& acc, int brow, int bcol, int wr, int wc, int fr, int fq) const {
        AccT z;
        LAS unsigned char* lds = (LAS unsigned char*)smem;
        LAS f32x2* P = (LAS f32x2*)(lds + 131072);
        LAS f32x2* Tb = (LAS f32x2*)(lds + 131072 + 8192);
        const int lane = fq * 16 + fr, tid = (wr * 4 + wc) * 64 + lane;
        const int pm = brow >> 8, pn = bcol >> 8;
#pragma unroll
        for (int ai = 0; ai < 2; ++ai)
#pragma unroll
            for (int m = 0; m < 4; ++m) {
                const int row = brow + ai * 128 + wr * 64 + m * 16 + fr;
                const float* hp = hs + (long)row * 1024 + bcol + wc * 32 + fq * 8;
                float sm = 0.f, sq = 0.f;
#pragma unroll
                for (int bj = 0; bj < 2; ++bj)
#pragma unroll
                    for (int n = 0; n < 2; ++n) {
                        const f32x4 hv = *(const f32x4*)(hp + bj * 128 + n * 4);
                        const f32x4 v = hv * ALPHA + acc[ai][bj][m][n];
                        z[ai][bj][m][n] = v;
                        sm += (v[0] + v[1]) + (v[2] + v[3]); sq += (v[0] * v[0] + v[1] * v[1]) + (v[2] * v[2] + v[3] * v[3]);
                    }
                sm += shx(sm, 16, lane); sq += shx(sq, 16, lane); sm += shx(sm, 32, lane); sq += shx(sq, 32, lane);
                if (fq == 0) P[(ai * 128 + wr * 64 + m * 16 + fr) * 4 + wc] = (f32x2){sm, sq};
                if (m & 1) asm volatile("" ::: "memory");
            }
        __syncthreads();
        if (tid < 256) {
            float sm = 0.f, sq = 0.f;
#pragma unroll
            for (int k = 0; k < 4; ++k) { const f32x2 v = P[tid * 4 + k]; sm += v[0]; sq += v[1]; }
            const unsigned long long pk = (unsigned long long)__float_as_uint(sm) | ((unsigned long long)__float_as_uint(sq) << 32);
            __hip_atomic_store(xbuf + ((long)(pm * 4 + pn) * 256 + tid), pk, __ATOMIC_RELAXED, __HIP_MEMORY_SCOPE_AGENT);
        }
        asm volatile("s_waitcnt vmcnt(0)" ::: "memory");
        __syncthreads();
        if (tid == 0) {
            unsigned* c = cnt + pm * 16;
            __hip_atomic_fetch_add(c, 1u, __ATOMIC_RELAXED, __HIP_MEMORY_SCOPE_AGENT);
            unsigned sp = 0;
            while (__hip_atomic_load(c, __ATOMIC_RELAXED, __HIP_MEMORY_SCOPE_AGENT) < 4u) { __builtin_amdgcn_s_sleep(1); if (++sp > (1u << 22)) break; }
        }
        __syncthreads();
        if (tid < 256) {
            float sm = 0.f, sq = 0.f;
#pragma unroll
            for (int k = 0; k < 4; ++k) {
                const unsigned long long v = __hip_atomic_load(xbuf + ((long)(pm * 4 + k) * 256 + tid), __ATOMIC_RELAXED, __HIP_MEMORY_SCOPE_AGENT);
                sm += __uint_as_float((unsigned)(v & 0xffffffffull)); sq += __uint_as_float((unsigned)(v >> 32));
            }
            const float mu = sm * (1.f / 1024.f), var = fmaxf(sq * (1.f / 1024.f) - mu * mu, 0.f);
            Tb[tid] = (f32x2){mu, 1.0f / sqrtf(var + 1e-5f)};
        }
        __syncthreads();
        f32x4 gv[2][2], bv[2][2];
#pragma unroll
        for (int bj = 0; bj < 2; ++bj)
#pragma unroll
            for (int n = 0; n < 2; ++n) { const int col = bcol + bj * 128 + wc * 32 + fq * 8 + n * 4; gv[bj][n] = *(const f32x4*)(g + col); bv[bj][n] = *(const f32x4*)(b + col); }
#pragma unroll
        for (int ai = 0; ai < 2; ++ai)
#pragma unroll
            for (int m = 0; m < 4; ++m) {
                const int rl = ai * 128 + wr * 64 + m * 16 + fr; const long row = brow + rl;
                const f32x2 t = Tb[rl]; const float ra = t[1], rc = -t[0] * t[1];
#pragma unroll
                for (int bj = 0; bj < 2; ++bj) {
                    const f32x4 y0 = (z[ai][bj][m][0] * ra + rc) * gv[bj][0] + bv[bj][0], y1 = (z[ai][bj][m][1] * ra + rc) * gv[bj][1] + bv[bj][1];
                    const long idx = row * 1024 + bcol + bj * 128 + wc * 32 + fq * 8;
                    *(f32x4*)(outh + idx) = y0; *(f32x4*)(outh + idx + 4) = y1;
                    *(u32x4*)(outb + idx) = (u32x4){pk2(y0[0], y0[1]), pk2(y0[2], y0[3]), pk2(y1[0], y1[1]), pk2(y1[2], y1[3])};
                }
                asm volatile("" ::: "memory");
            }
        __syncthreads();
    }
};

DI void phase_convert(const Params& p, int wv) {
    bf16_t* W = (bf16_t*)(wsptr(p) + OFF_W);
    LAS bf16_t* tile = (LAS bf16_t*)smem;
    const int tid_ = phase_tid(wv); const int tid = tid_;
    for (int t4 = blockIdx.x * 4; t4 < p.conv_tiles; t4 += gridDim.x * 4) {
        int di = 0;
#pragma unroll 1
        for (int i = 1; i < 18; ++i) { int ii = i; asm volatile("" : "+s"(ii)); if (t4 >= p.cd[ii].tile0) di = ii; }
        asm volatile("" : "+s"(di));
        const int K = p.cd[di].K, Nsrc = p.cd[di].Nsrc, perm = p.cd[di].perm, tile0 = p.cd[di].tile0, in_idx = p.cd[di].in_idx;
        const float* src = inptr(p, in_idx) + p.cd[di].src_off;
        bf16_t* dst = W + p.cd[di].dst_off;
        const int ntk = K / 64;
        const int kl = tid >> 4, n4 = (tid & 15) * 4;
        f32x4 v[4][2];
#pragma unroll
        for (int j = 0; j < 4; ++j) {
            const int lt = t4 + j - tile0, kt = lt % ntk, ntile = lt / ntk, k0 = kt * 64, n0 = ntile * 64;
            const int sc0 = perm ? ((n0 & 255) >> 7) * FFH + (n0 >> 8) * 128 + (n0 & 127) : n0;
#pragma unroll
            for (int i = 0; i < 2; ++i) {
                const int k = k0 + kl + 32 * i;
                v[j][i] = (f32x4){0.f, 0.f, 0.f, 0.f};
                if (sc0 + n4 < Nsrc) v[j][i] = *(const f32x4*)(src + (long)k * Nsrc + sc0 + n4);
            }
        }
#pragma unroll
        for (int j = 0; j < 4; ++j)
#pragma unroll
            for (int i = 0; i < 2; ++i)
#pragma unroll
                for (int e = 0; e < 4; ++e) { const int c64 = n4 + e, c = c64 & 31, slot = (c64 & 32) + 16 * ((c >> 2) & 1) + 4 * (c >> 3) + (c & 3); tile[j * 4608 + slot * 72 + kl + 32 * i] = f2bf(v[j][i][e]); }
        __syncthreads();
#pragma unroll
        for (int j = 0; j < 4; ++j) {
            const int lt = t4 + j - tile0, kt = lt % ntk, ntile = lt / ntk, k0 = kt * 64, n0 = ntile * 64;
            const int n = tid >> 3, kc = (tid & 7) * 8;
            const u32x4 w = *(const LAS u32x4*)(tile + j * 4608 + n * 72 + kc);
            *(u32x4*)(dst + (long)(n0 + n) * K + k0 + kc) = w;
        }
        __syncthreads();
    }
    { const float* x = inptr(p, 0); bf16_t* hb = (bf16_t*)(wsptr(p) + OFF_HB);
      const long n8 = (long)T_ * 1024 / 8;
      for (long i = (long)blockIdx.x * NTHR + tid; i < n8; i += (long)gridDim.x * NTHR) {
          const f32x4 a = *(const f32x4*)(x + i * 8), b = *(const f32x4*)(x + i * 8 + 4);
          u32x4 w = {pk2(a[0], a[1]), pk2(a[2], a[3]), pk2(b[0], b[1]), pk2(b[2], b[3])};
          *(u32x4*)(hb + i * 8) = w;
      } }
    { float* ct = (float*)(wsptr(p) + OFF_COS); float* st = (float*)(wsptr(p) + OFF_SIN);
      const float inv = (float)pow(10000.0, -(double)(tid & 31) / 32.0);
      for (int i = blockIdx.x * NTHR + tid; i < S_ * 32; i += gridDim.x * NTHR) {
          const int pos = i >> 5;
          const float ang = (float)pos * inv;
          float sv, cv; sincosf(ang, &sv, &cv); ct[i] = cv; st[i] = sv;
      } }
}

DI void phase_ln(int wv, const float* h, float* hout, bf16_t* hb, float* stat, const float* g, const float* bt, bool final_out) {
    const int tid_ = phase_tid(wv); const int tid = tid_, wid = tid >> 6, lane = tid & 63;
    const int nw = gridDim.x * 8;
    f32x4 gv[4], bv[4];
#pragma unroll
    for (int i = 0; i < 4; ++i) { gv[i] = *(const f32x4*)(g + i * 256 + lane * 4); bv[i] = *(const f32x4*)(bt + i * 256 + lane * 4); }
    for (int row = blockIdx.x * 8 + wid; row < T_; row += nw) {
        f32x4 v[4]; float s = 0.f;
#pragma unroll
        for (int i = 0; i < 4; ++i) { v[i] = *(const f32x4*)(h + (long)row * 1024 + i * 256 + lane * 4); s += (v[i][0] + v[i][1]) + (v[i][2] + v[i][3]); }
#pragma unroll
        for (int o = 32; o >= 1; o >>= 1) s += shx(s, o, lane);
        const float mu = s * (1.f / 1024.f); float q = 0.f;
#pragma unroll
        for (int i = 0; i < 4; ++i) { const f32x4 d = v[i] - mu; q += (d[0] * d[0] + d[1] * d[1]) + (d[2] * d[2] + d[3] * d[3]); }
#pragma unroll
        for (int o = 32; o >= 1; o >>= 1) q += shx(q, o, lane);
        const float rstd = 1.0f / sqrtf(q * (1.f / 1024.f) + 1e-5f);
        const float ra = rstd, rc = -mu * rstd;
        if (final_out) {
#pragma unroll
            for (int i = 0; i < 4; ++i) *(f32x4*)(hout + (long)row * 1024 + i * 256 + lane * 4) = (v[i] * ra + rc) * gv[i] + bv[i];
        } else {
            if (lane == 0) *(f32x2*)(stat + (long)row * 2) = (f32x2){mu, rstd};
#pragma unroll
            for (int i = 0; i < 4; ++i) {
                const f32x4 y = (v[i] * ra + rc) * gv[i] + bv[i];
                u32x2 w = {pk2(y[0], y[1]), pk2(y[2], y[3])};
                *(u32x2*)(hb + (long)row * 1024 + i * 256 + lane * 4) = w;
            }
        }
    }
}

DI void phase_mla_norm(const Params& p, int wv) {
    const int tid_ = phase_tid(wv); const int tid = tid_, wid = tid >> 6, lane = tid & 63;
    bf16_t* C = (bf16_t*)(wsptr(p) + OFF_Y);
    bf16_t* KR = (bf16_t*)(wsptr(p) + OFF_P + MP_KR);
    const float* ct = (const float*)(wsptr(p) + OFF_COS); const float* st = (const float*)(wsptr(p) + OFF_SIN);
    const float* gq = inptr(p, 10); const float* gkv = inptr(p, 11);
    float gqv[6], gkvv[4];
#pragma unroll
    for (int e = 0; e < 6; ++e) gqv[e] = gq[lane * 6 + e];
#pragma unroll
    for (int e = 0; e < 4; ++e) gkvv[e] = gkv[lane * 4 + e];
    const int nw = gridDim.x * 8;
    for (int row = blockIdx.x * 8 + wid; row < T_; row += nw) {
        bf16_t* cr = C + (long)row * 768;
        unsigned* cq = (unsigned*)(cr + lane * 6);
        const unsigned q0 = cq[0], q1 = cq[1], q2 = cq[2];
        float xq[6] = {bflo(q0), bfhi(q0), bflo(q1), bfhi(q1), bflo(q2), bfhi(q2)};
        u32x2* ck = (u32x2*)(cr + 384 + lane * 4);
        const u32x2 kk = *ck;
        float xk[4] = {bflo(kk[0]), bfhi(kk[0]), bflo(kk[1]), bfhi(kk[1])};
        const float tr = bf2f(cr[640 + lane]);
        float sq = 0.f, sk = 0.f;
#pragma unroll
        for (int e = 0; e < 6; ++e) sq += xq[e] * xq[e];
#pragma unroll
        for (int e = 0; e < 4; ++e) sk += xk[e] * xk[e];
#pragma unroll
        for (int o = 32; o >= 1; o >>= 1) { sq += shx(sq, o, lane); sk += shx(sk, o, lane); }
        const float rq = 1.0f / sqrtf(sq * (1.f / 384.f) + 1e-6f), rk = 1.0f / sqrtf(sk * (1.f / 256.f) + 1e-6f);
        cq[0] = pk2(xq[0] * rq * gqv[0], xq[1] * rq * gqv[1]);
        cq[1] = pk2(xq[2] * rq * gqv[2], xq[3] * rq * gqv[3]);
        cq[2] = pk2(xq[4] * rq * gqv[4], xq[5] * rq * gqv[5]);
        u32x2 w = {pk2(xk[0] * rk * gkvv[0], xk[1] * rk * gkvv[1]), pk2(xk[2] * rk * gkvv[2], xk[3] * rk * gkvv[3])};
        *ck = w;
        const float pr = shx(tr, 32, lane);
        const int pos = row % S_, f = lane & 31;
        const float c = ct[pos * 32 + f], s = st[pos * 32 + f];
        const float o = (lane < 32) ? (tr * c - pr * s) : (pr * s + tr * c);
        KR[(long)row * 64 + lane] = f2bf(o);
    }
}

constexpr int MK_STR = 400, MV_STR = 144, MK_BYTES = 64 * MK_STR, MV_BYTES = 128 * MV_STR;
constexpr int MV_BASE = 2 * MK_BYTES, MQR_BASE = MV_BASE + 3 * MV_BYTES;
DI void phase_mla_attn(const Params& p, int wv) {
    LAS unsigned char* lds = (LAS unsigned char*)smem;
    const bf16_t* Q = (const bf16_t*)(wsptr(p) + OFF_P + MP_Q); const bf16_t* KN = (const bf16_t*)(wsptr(p) + OFF_P + MP_KN);
    const bf16_t* VT = (const bf16_t*)(wsptr(p) + OFF_P + MP_VT); const bf16_t* KR = (const bf16_t*)(wsptr(p) + OFF_P + MP_KR);
    bf16_t* Y = (bf16_t*)(wsptr(p) + OFF_Y);
    const float* ct = (const float*)(wsptr(p) + OFF_COS); const float* st = (const float*)(wsptr(p) + OFF_SIN);
    const int tid_ = phase_tid(wv); const int tid = tid_, wid = __builtin_amdgcn_readfirstlane(tid >> 6), lane = tid & 63, l32 = lane & 31, g = lane >> 5;
    const int G = gridDim.x, vcu = vcu_of_block();
    const bool grpB = wid >= 4;
    for (int pi = vcu; pi < 512; pi += G) {
        const int bh = pi >> 5, pp = pi & 31, b = bh >> 3, h = bh & 7;
        for (int half = 0; half < 2; ++half) {
            const int qt = half ? pp : (63 - pp);
            const int cq = qt * 4 + (wid >> 1), ntiles = qt * 4 + 4;
            bf16x8 q[6];
            LAS unsigned char* qr = lds + MQR_BASE + wid * 6144 + lane * 16;
            { const char* qpb = (const char*)(Q + ((long)b * S_ + qt * 256) * 1536 + h * 192);
              const unsigned qoff = (unsigned)((wid * 32 + l32) * 1536 + g * 8) * 2u;
              bf16x8 qro[4];
#pragma unroll
              for (int s = 0; s < 4; ++s) qro[s] = *(const bf16x8*)(qpb + qoff + 32 * (8 + s));
#pragma unroll
              for (int s = 0; s < 6; ++s) q[s] = *(const bf16x8*)(qpb + qoff + 32 * s);
#pragma unroll
              for (int s = 6; s < 8; ++s) *(LAS bf16x8*)(qr + (s - 2) * 1024) = *(const bf16x8*)(qpb + qoff + 32 * s);
              const char* ctb = (const char*)(ct + (long)qt * 256 * 32); const char* stb = (const char*)(st + (long)qt * 256 * 32);
              const unsigned toff = (unsigned)((wid * 32 + l32) * 32 + 8 * g) * 4u;
#pragma unroll
              for (int ss = 0; ss < 2; ++ss) {
                  const f32x4 c0 = *(const f32x4*)(ctb + toff + 64 * ss), c1 = *(const f32x4*)(ctb + toff + 64 * ss + 16);
                  const f32x4 s0 = *(const f32x4*)(stb + toff + 64 * ss), s1 = *(const f32x4*)(stb + toff + 64 * ss + 16);
                  float o1[8], o2[8];
#pragma unroll
                  for (int e = 0; e < 8; ++e) {
                      const float c = e < 4 ? c0[e & 3] : c1[e & 3], s = e < 4 ? s0[e & 3] : s1[e & 3];
                      const float t1 = bf2f((unsigned short)qro[ss][e]), t2 = bf2f((unsigned short)qro[2 + ss][e]);
                      o1[e] = t1 * c - t2 * s; o2[e] = t1 * s + t2 * c;
                  }
                  *(LAS bf16x8*)(qr + ss * 1024) = pack8(o1[0], o1[1], o1[2], o1[3], o1[4], o1[5], o1[6], o1[7]);
                  *(LAS bf16x8*)(qr + (2 + ss) * 1024) = pack8(o2[0], o2[1], o2[2], o2[3], o2[4], o2[5], o2[6], o2[7]);
              } }
            f32x16 o[4]; for (int i = 0; i < 4; ++i) o[i] = zero16();
            float mrun = -1e30f, lsum = 0.f;
            u32x4 kreg[3], vreg[2];
            const long key_base = (long)b * S_;
            const unsigned kn_off = (unsigned)((tid >> 4) * 1024 + (tid & 15) * 8) * 2u, kr_off = (unsigned)((tid >> 3) * 64 + (tid & 7) * 8) * 2u, vt_off = (unsigned)((tid >> 3) * S_ + (tid & 7) * 8) * 2u;
#define MLA_GLOAD(kt) do { const long k0 = key_base + (long)(kt) * 64; \
    const char* knb = (const char*)(KN + k0 * 1024 + h * 128); const char* krb = (const char*)(KR + k0 * 64); \
    const char* vtb = (const char*)(VT + ((long)(b * 1024 + h * 128)) * S_ + (long)(kt) * 64); \
    kreg[0] = *(const u32x4*)(knb + kn_off); kreg[1] = *(const u32x4*)(knb + 65536 + kn_off); \
    kreg[2] = *(const u32x4*)(krb + kr_off); \
    vreg[0] = *(const u32x4*)(vtb + vt_off); vreg[1] = *(const u32x4*)(vtb + 64L * S_ * 2 + vt_off); } while (0)
#define MLA_LWRITE(kbufp, vbufp) do { LAS unsigned char* _kp = (kbufp); LAS unsigned char* _vp = (vbufp); \
    { const int id = tid; *(LAS u32x4*)(_kp + (id >> 4) * MK_STR + (id & 15) * 16) = kreg[0]; } \
    { const int id = tid + 512; *(LAS u32x4*)(_kp + (id >> 4) * MK_STR + (id & 15) * 16) = kreg[1]; } \
    *(LAS u32x4*)(_kp + (tid >> 3) * MK_STR + 256 + (tid & 7) * 16) = kreg[2]; \
    { const int id = tid; *(LAS u32x4*)(_vp + (id >> 3) * MV_STR + (id & 7) * 16) = vreg[0]; } \
    { const int id = tid + 512; *(LAS u32x4*)(_vp + (id >> 3) * MV_STR + (id & 7) * 16) = vreg[1]; } } while (0)
            auto do_qk = [&](f32x16& s0, f32x16& s1, LAS unsigned char* kbuf) {
                s0 = zero16(); s1 = zero16();
                LAS unsigned char* kb = kbuf + ((l32 & 19) | ((l32 & 4) << 1) | ((l32 & 8) >> 1)) * MK_STR + g * 16;
                __builtin_amdgcn_s_setprio(1);
#pragma unroll
                for (int s = 0; s < 12; ++s) {
                    const bf16x8 a0 = *(const LAS bf16x8*)(kb + s * 32), a1 = *(const LAS bf16x8*)(kb + 32 * MK_STR + s * 32);
                    const bf16x8 qv = (s < 6) ? q[s < 6 ? s : 0] : *(const LAS bf16x8*)(qr + (s < 8 ? s - 2 : s - 8) * 1024);
                    s0 = MFMA32(a0, qv, s0); s1 = MFMA32(a1, qv, s1);
                }
                __builtin_amdgcn_s_setprio(0);
            };
            auto do_sm_pv = [&](f32x16& s0, f32x16& s1, LAS unsigned char* vbuf) {
                float mx = s0[0];
#pragma unroll
                for (int i = 0; i < 16; ++i) { mx = fmaxf(mx, s0[i]); mx = fmaxf(mx, s1[i]); }
                mx = xh_max(mx);
                const bool fire = __builtin_amdgcn_ballot_w64(mx - mrun > 8.0f) != 0ull;
                const float mnew = fire ? fmaxf(mrun, mx) : mrun, alpha = __builtin_amdgcn_exp2f(mrun - mnew);
                mrun = mnew;
                float ps = 0.f;
#pragma unroll
                for (int i = 0; i < 16; ++i) { s0[i] = __builtin_amdgcn_exp2f(s0[i] - mnew); s1[i] = __builtin_amdgcn_exp2f(s1[i] - mnew); ps += s0[i] + s1[i]; }
                lsum = lsum * alpha + ps;
                if (fire) {
#pragma unroll
                    for (int t = 0; t < 4; ++t) o[t] = o[t] * alpha;
                }
                bf16x8 pb[4] = {pack_lo(s0), pack_hi(s0), pack_lo(s1), pack_hi(s1)};
                LAS unsigned char* vb = vbuf + l32 * MV_STR + g * 16;
                __builtin_amdgcn_s_setprio(1);
#pragma unroll
                for (int dvt = 0; dvt < 4; ++dvt)
#pragma unroll
                    for (int ss = 0; ss < 4; ++ss) {
                        const bf16x8 a8 = *(const LAS bf16x8*)(vb + dvt * 32 * MV_STR + ss * 32);
                        o[dvt] = MFMA32(a8, pb[ss], o[dvt]);
                    }
                __builtin_amdgcn_s_setprio(0);
            };
            const bool rev = half != 0;
#define KT(i) (rev ? (ntiles - 1 - (i)) : (i))
            MLA_GLOAD(KT(0)); MLA_LWRITE(lds, lds + MV_BASE); __syncthreads();
            if (!grpB) {
                int vcur = 0;
                for (int i = 0; i < ntiles; ++i) {
                    const int vnext = vcur == 2 ? 0 : vcur + 1;
                    if (i + 1 < ntiles) MLA_GLOAD(KT(i + 1));
                    if (KT(i) <= cq) { f32x16 s0, s1; do_qk(s0, s1, lds + (i & 1) * MK_BYTES); do_sm_pv(s0, s1, lds + MV_BASE + vcur * MV_BYTES); }
                    if (i + 1 < ntiles) MLA_LWRITE(lds + ((i + 1) & 1) * MK_BYTES, lds + MV_BASE + vnext * MV_BYTES);
                    __syncthreads();
                    vcur = vnext;
                }
            } else {
                int vcur = 0;
                f32x16 s0 = zero16(), s1 = zero16();
                for (int i = 0; i < ntiles; ++i) {
                    const int vprev = vcur == 0 ? 2 : vcur - 1, vnext = vcur == 2 ? 0 : vcur + 1;
                    if (i + 1 < ntiles) MLA_GLOAD(KT(i + 1));
                    if (i >= 1 && KT(i - 1) <= cq) do_sm_pv(s0, s1, lds + MV_BASE + vprev * MV_BYTES);
                    if (KT(i) <= cq) do_qk(s0, s1, lds + (i & 1) * MK_BYTES);
                    if (i + 1 < ntiles) MLA_LWRITE(lds + ((i + 1) & 1) * MK_BYTES, lds + MV_BASE + vnext * MV_BYTES);
                    __syncthreads();
                    vcur = vnext;
                }
                if (KT(ntiles - 1) <= cq) { const int vlast = vcur == 0 ? 2 : vcur - 1; do_sm_pv(s0, s1, lds + MV_BASE + vlast * MV_BYTES); }
            }
#undef KT
            const float ltot = xh_sum(lsum), inv = 1.f / ltot;
            char* ypb = (char*)(Y + ((long)b * S_ + qt * 256) * 1024 + h * 128);
            const unsigned yoff = (unsigned)((wid * 32 + l32) * 1024 + 4 * g) * 2u;
#pragma unroll
            for (int dvt = 0; dvt < 4; ++dvt)
#pragma unroll
                for (int a = 0; a < 4; ++a) {
                    u32x2 w = {pk2(o[dvt][4 * a] * inv, o[dvt][4 * a + 1] * inv), pk2(o[dvt][4 * a + 2] * inv, o[dvt][4 * a + 3] * inv)};
                    *(u32x2*)(ypb + yoff + (dvt * 32 + a * 8) * 2) = w;
                }
            __syncthreads();
        }
    }
#undef MLA_GLOAD
#undef MLA_LWRITE
}

constexpr int RK_STR = 144, RV_STR = 136, RK_BYTES = 64 * RK_STR, RV_BYTES = 64 * RV_STR, RBUF = RK_BYTES + RV_BYTES, R_BIAS_OFF = 3 * RBUF;
DI void phase_rpa_attn(const Params& p, int wv) {
    LAS unsigned char* lds = (LAS unsigned char*)smem;
    const bf16_t* Q = (const bf16_t*)(wsptr(p) + OFF_P + RP_Q); const bf16_t* Kp = (const bf16_t*)(wsptr(p) + OFF_P + RP_K);
    const bf16_t* VT = (const bf16_t*)(wsptr(p) + OFF_P + RP_VT);
    bf16_t* Y = (bf16_t*)(wsptr(p) + OFF_Y);
    const float* relb = inptr(p, 7);
    LAS float* bias = (LAS float*)(lds + R_BIAS_OFF);
    const int tid_ = phase_tid(wv); const int tid = tid_, wid = __builtin_amdgcn_readfirstlane(tid >> 6), lane = tid & 63, l32 = lane & 31, g = lane >> 5;
    const int G = gridDim.x, vcu = vcu_of_block();
    for (int u = vcu; u < 2048; u += G) {
        const int bh = u >> 6, grp = u & 63, b = bh >> 4, h = bh & 15;
        const int c = grp * 4 + (wid >> 1);
        const int qi = (wid & 1) * 32 + l32;
        const long tok = (long)b * S_ + c * 64 + qi;
        bf16x8 q[4];
        { const bf16_t* qp = Q + tok * 1024 + h * 64 + g * 8;
#pragma unroll
          for (int s = 0; s < 4; ++s) q[s] = *(const bf16x8*)(qp + 16 * s); }
        if (tid < 257) bias[tid] = relb[h * 257 + tid] * LOG2E;
        f32x16 o[2] = {zero16(), zero16()};
        float mrun = -1e30f, lsum = 0.f;
        u32x4 kreg0, vreg0, kreg1, vreg1;
        const unsigned rk_off = (unsigned)((tid >> 3) * 1024 + (tid & 7) * 8) * 2u, rv_off = (unsigned)((tid >> 3) * S_ + (tid & 7) * 8) * 2u;
        const int kc0 = max(0, grp * 4 - 8), kc1 = grp * 4 + 3, ntl = kc1 - kc0 + 1;
#define RPA_GLOAD(kc, KR_, VR_) do { const long k0 = (long)b * S_ + (long)(kc) * 64; \
    const char* kb_ = (const char*)(Kp + k0 * 1024 + h * 64); const char* vtb = (const char*)(VT + ((long)(b * 1024 + h * 64)) * S_ + (long)(kc) * 64); \
    KR_ = *(const u32x4*)(kb_ + rk_off); VR_ = *(const u32x4*)(vtb + rv_off); } while (0)
#define RPA_LWRITE(bufp, KR_, VR_) do { LAS unsigned char* _bp = (bufp); \
    *(LAS u32x4*)(_bp + (tid >> 3) * RK_STR + (tid & 7) * 16) = KR_; \
    { LAS unsigned char* a = _bp + RK_BYTES + (tid >> 3) * RV_STR + (tid & 7) * 16; \
      *(LAS u32x2*)a = (u32x2){VR_[0], VR_[1]}; *(LAS u32x2*)(a + 8) = (u32x2){VR_[2], VR_[3]}; } } while (0)
        auto tile = [&](int kc, LAS unsigned char* buf) {
            if (kc <= c && kc >= c - 8) {
                f32x16 s0 = zero16(), s1 = zero16();
                LAS unsigned char* kb = buf + l32 * RK_STR + g * 16;
#pragma unroll
                for (int s = 0; s < 4; ++s) {
                    const bf16x8 a0 = *(const LAS bf16x8*)(kb + s * 32), a1 = *(const LAS bf16x8*)(kb + 32 * RK_STR + s * 32);
                    s0 = MFMA32(a0, q[s], s0); s1 = MFMA32(a1, q[s], s1);
                }
                const int dist = c - kc;
                if (dist >= 3) {
                    const float bc = bias[256];
#pragma unroll
                    for (int i = 0; i < 16; ++i) { s0[i] += bc; s1[i] += bc; }
                } else {
                    const int base = dist * 64 + qi - 4 * g;
#pragma unroll
                    for (int i = 0; i < 16; ++i) {
                        const int kj = 8 * (i >> 2) + (i & 3);
                        const int r0 = base - kj, r1 = base - kj - 32;
                        s0[i] += bias[min(r0, 128) + 128]; s1[i] += bias[min(r1, 128) + 128];
                    }
                }
                float mx = s0[0];
#pragma unroll
                for (int i = 0; i < 16; ++i) { mx = fmaxf(mx, s0[i]); mx = fmaxf(mx, s1[i]); }
                mx = xh_max(mx);
                if (__builtin_amdgcn_ballot_w64(mx - mrun > 8.0f) != 0ull) {
                    const float mnew = fmaxf(mrun, mx), alpha = __builtin_amdgcn_exp2f(mrun - mnew); mrun = mnew;
                    lsum *= alpha; o[0] = o[0] * alpha; o[1] = o[1] * alpha;
                }
                float ps = 0.f;
#pragma unroll
                for (int i = 0; i < 16; ++i) { s0[i] = __builtin_amdgcn_exp2f(s0[i] - mrun); s1[i] = __builtin_amdgcn_exp2f(s1[i] - mrun); ps += s0[i] + s1[i]; }
                lsum += ps;
                bf16x8 pb[4] = {pack_lo(s0), pack_hi(s0), pack_lo(s1), pack_hi(s1)};
                LAS unsigned char* vb = buf + RK_BYTES + l32 * RV_STR + g * 8;
#pragma unroll
                for (int dvt = 0; dvt < 2; ++dvt)
#pragma unroll
                    for (int ss = 0; ss < 4; ++ss) {
                        const u32x2 lo = *(const LAS u32x2*)(vb + dvt * 32 * RV_STR + ss * 32), hi = *(const LAS u32x2*)(vb + dvt * 32 * RV_STR + ss * 32 + 16);
                        u32x4 a4 = {lo[0], lo[1], hi[0], hi[1]};
                        o[dvt] = MFMA32(__builtin_bit_cast(bf16x8, a4), pb[ss], o[dvt]);
                    }
            }
        };
        RPA_GLOAD(kc0, kreg0, vreg0); RPA_GLOAD(kc0 + 1, kreg1, vreg1);
        RPA_LWRITE(lds, kreg0, vreg0); __syncthreads();
        int slot = 0;
        for (int it = 0; it < ntl; it += 2) {
            const int s1_ = slot == 2 ? 0 : slot + 1, s2_ = s1_ == 2 ? 0 : s1_ + 1;
            if (it + 2 < ntl) RPA_GLOAD(kc0 + it + 2, kreg0, vreg0);
            tile(kc0 + it, lds + slot * RBUF);
            RPA_LWRITE(lds + s1_ * RBUF, kreg1, vreg1);
            __syncthreads();
            if (it + 3 < ntl) RPA_GLOAD(kc0 + it + 3, kreg1, vreg1);
            tile(kc0 + it + 1, lds + s1_ * RBUF);
            if (it + 2 < ntl) RPA_LWRITE(lds + s2_ * RBUF, kreg0, vreg0);
            __syncthreads();
            slot = s2_;
        }
        const float ltot = xh_sum(lsum), inv = 1.f / ltot;
        bf16_t* yp = Y + tok * 1024 + h * 64 + 4 * g;
#pragma unroll
        for (int dvt = 0; dvt < 2; ++dvt)
#pragma unroll
            for (int a = 0; a < 4; ++a) {
                u32x2 w = {pk2(o[dvt][4 * a] * inv, o[dvt][4 * a + 1] * inv), pk2(o[dvt][4 * a + 2] * inv, o[dvt][4 * a + 3] * inv)};
                *(u32x2*)(yp + dvt * 32 + a * 8) = w;
            }
    }
}

DI void phase_gla_prep(const Params& p, int wv, int j) {
    LAS float* gl = (LAS float*)smem;
    LAS float* part = gl + 1024;
    bf16_t* Pb = (bf16_t*)(wsptr(p) + OFF_P);
    bf16_t* Q = Pb + GP_Q / 2; bf16_t* K = Pb + GP_K / 2; bf16_t* KT = Pb + GP_KT / 2;
    const float* GL = (const float*)(wsptr(p) + OFF_P + GP_GL);
    float* decay = (float*)(wsptr(p) + OFF_DECAY);
    const float* wg = inptr(p, 2) + (long)j * 16 * 512; const float* bg = inptr(p, 3) + (long)j * 512;
    const int tid_ = phase_tid(wv); const int tid = tid_, d0 = (tid & 63) * 2, tq = tid >> 6;
    f32x4 ngl = {0.f, 0.f, 0.f, 0.f}; f32x2 nw[16]; f32x2 nbg = {0.f, 0.f}; unsigned nqw[8], nkw[8];
#define GP_LOAD(uu) do { const int h_ = (uu) & 3, bc_ = (uu) >> 2, b_ = bc_ >> 8, c_ = bc_ & 255; const long t0_ = (long)b_ * S_ + c_ * 64; \
    if (tid < 256) ngl = *(const f32x4*)(GL + t0_ * 16 + tid * 4); \
    _Pragma("unroll") for (int r = 0; r < 16; ++r) nw[r] = *(const f32x2*)(wg + r * 512 + h_ * 128 + d0); \
    nbg = *(const f32x2*)(bg + h_ * 128 + d0); \
    _Pragma("unroll") for (int i = 0; i < 8; ++i) { const long idx_ = (t0_ + tq * 8 + i) * 512 + h_ * 128 + d0; nqw[i] = *(const unsigned*)(Q + idx_); nkw[i] = *(const unsigned*)(K + idx_); } } while (0)
    if ((int)blockIdx.x < 2048) GP_LOAD(blockIdx.x);
    for (int u = blockIdx.x; u < 2048; u += gridDim.x) {
        const int h = u & 3, bc = u >> 2, b = bc >> 8, c = bc & 255;
        const long tok0 = (long)b * S_ + c * 64;
        if (tid < 256) *(LAS f32x4*)(gl + tid * 4) = ngl;
        f32x2 w[16]; unsigned qw8[8], kw8[8];
#pragma unroll
        for (int r = 0; r < 16; ++r) w[r] = nw[r];
#pragma unroll
        for (int i = 0; i < 8; ++i) { qw8[i] = nqw[i]; kw8[i] = nkw[i]; }
        const f32x2 bgv = nbg;
        __syncthreads();
        f32x2 la[8]; f32x2 run = {0.f, 0.f};
#pragma unroll
        for (int i = 0; i < 8; ++i) {
            const int t = tq * 8 + i; f32x2 lg = bgv;
#pragma unroll
            for (int r4 = 0; r4 < 4; ++r4) { const f32x4 gq = *(const LAS f32x4*)(gl + t * 16 + 4 * r4);
                lg += w[4 * r4] * gq[0] + w[4 * r4 + 1] * gq[1] + w[4 * r4 + 2] * gq[2] + w[4 * r4 + 3] * gq[3]; }
            f32x2 ls;
            ls[0] = fminf(lg[0], 0.f) - __logf(1.f + __expf(-fabsf(lg[0])));
            ls[1] = fminf(lg[1], 0.f) - __logf(1.f + __expf(-fabsf(lg[1])));
            run += ls * (1.f / 16.f); la[i] = run;
        }
        *(LAS f32x2*)(part + tq * 128 + d0) = run;
        __syncthreads();
        if (u + (int)gridDim.x < 2048) GP_LOAD(u + gridDim.x);
        f32x2 off = {0.f, 0.f}, tot = {0.f, 0.f};
#pragma unroll
        for (int k = 0; k < 8; ++k) { const f32x2 v = *(const LAS f32x2*)(part + k * 128 + d0); tot += v; if (k < tq) off += v; }
        unsigned kt0[4], kt1[4];
        float kp0 = 0.f, kp1 = 0.f;
#pragma unroll
        for (int i = 0; i < 8; ++i) {
            const int t = tq * 8 + i; const f32x2 cum = la[i] + off;
            const long idx = (tok0 + t) * 512 + h * 128 + d0;
            const unsigned qw = qw8[i], kw = kw8[i];
            const float q0 = bflo(qw) * 0.08838834764831845f * __expf(cum[0]), q1 = bfhi(qw) * 0.08838834764831845f * __expf(cum[1]);
            const float k0 = bflo(kw) * __expf(-cum[0]), k1 = bfhi(kw) * __expf(-cum[1]);
            *(unsigned*)(Q + idx) = pk2(q0, q1); *(unsigned*)(K + idx) = pk2(k0, k1);
            if (i & 1) { kt0[i >> 1] = pk2(kp0, k0); kt1[i >> 1] = pk2(kp1, k1); } else { kp0 = k0; kp1 = k1; }
        }
        { bf16_t* ktp = KT + ((long)(b * 512 + h * 128 + d0)) * S_ + c * 64 + tq * 8;
          *(u32x4*)ktp = (u32x4){kt0[0], kt0[1], kt0[2], kt0[3]}; *(u32x4*)(ktp + S_) = (u32x4){kt1[0], kt1[1], kt1[2], kt1[3]}; }
        if (tq == 7) *(f32x2*)(decay + ((long)(b * NCH + c)) * 512 + h * 128 + d0) = (f32x2){__expf(tot[0]), __expf(tot[1])};
        __syncthreads();
    }
#undef GP_LOAD
}

constexpr int GQ_STR = 264, GK_STR = 144, GQ_BYTES = 64 * GQ_STR, GK_BYTES = 128 * GK_STR, GBUF = GQ_BYTES + GK_BYTES + 512;
constexpr int NSEG = 32, SEGC = NCH / NSEG;
constexpr size_t OFF_X = OFF_HB, OFF_DS = OFF_HB + 40 * MiB;
template <bool WITH_O>
DI void phase_gla_scan(const Params& p, int wv) {
    LAS unsigned char* lds = (LAS unsigned char*)smem;
    const bf16_t* Pb = (const bf16_t*)(wsptr(p) + OFF_P);
    const bf16_t* Q = Pb + GP_Q / 2; const bf16_t* KT = Pb + GP_KT / 2; const bf16_t* VT = Pb + GP_VT / 2;
    const float* decay = (const float*)(wsptr(p) + OFF_DECAY);
    float* X = (float*)(wsptr(p) + OFF_X); float* DS = (float*)(wsptr(p) + OFF_DS);
    bf16_t* Y = (bf16_t*)(wsptr(p) + OFF_Y);
    const int tid_ = phase_tid(wv); const int tid = tid_, wid = __builtin_amdgcn_readfirstlane(tid >> 6), lane = tid & 63, l32 = lane & 31, g = lane >> 5;
    for (int u = blockIdx.x; u < 8 * NSEG; u += gridDim.x) {
        const int bh = u / NSEG, seg = u % NSEG, b = bh >> 2, h = bh & 3;
        const int c0 = seg * SEGC;
        const int dvc = h * 256 + wid * 32 + l32;
        f32x16 St[4]; bf16x8 Sb[8];
        float* xw = X + ((long)(bh * NSEG + seg)) * 32768 + wid * 4096 + lane;
        if (WITH_O) {
#pragma unroll
            for (int t = 0; t < 4; ++t) {
#pragma unroll
                for (int i = 0; i < 16; ++i) St[t][i] = xw[(t * 16 + i) * 64];
                Sb[2 * t] = pack_lo(St[t]); Sb[2 * t + 1] = pack_hi(St[t]);
            }
        } else {
            for (int t = 0; t < 4; ++t) St[t] = zero16();
            for (int s = 0; s < 8; ++s) Sb[s] = (bf16x8){0, 0, 0, 0, 0, 0, 0, 0};
            if (tid < 128) {
                float dp = 1.f;
                for (int c = 0; c < SEGC; ++c) dp *= decay[((long)(b * NCH + c0 + c)) * 512 + h * 128 + tid];
                DS[(bh * NSEG + seg) * 128 + tid] = dp;
            }
        }
        u32x4 qreg[2], kreg[2]; f32x4 dreg; bf16x8 vcur[4], vnext[4];
        const unsigned gq_off = (unsigned)((tid >> 4) * 512 + (tid & 15) * 8) * 2u, gk_off = (unsigned)((tid >> 3) * S_ + (tid & 7) * 8) * 2u, gv_off = (unsigned)(l32 * S_ + 8 * g) * 2u;
#define GLA_GLOAD(c) do { const long t0 = (long)b * S_ + (long)(c) * 64; \
    const char* qb_ = (const char*)(Q + t0 * 512 + h * 128); const char* ktb = (const char*)(KT + ((long)(b * 512 + h * 128)) * S_ + (long)(c) * 64); \
    const char* vtb = (const char*)(VT + ((long)(b * 1024 + h * 256 + wid * 32)) * S_ + (long)(c) * 64); \
    if (WITH_O) { qreg[0] = *(const u32x4*)(qb_ + gq_off); qreg[1] = *(const u32x4*)(qb_ + 32768 + gq_off); } \
    kreg[0] = *(const u32x4*)(ktb + gk_off); kreg[1] = *(const u32x4*)(ktb + 64L * S_ * 2 + gk_off); \
    if (tid < 32) dreg = *(const f32x4*)(decay + ((long)(b * NCH + (c))) * 512 + h * 128 + tid * 4); \
    _Pragma("unroll") for (int ks = 0; ks < 4; ++ks) vnext[ks] = *(const bf16x8*)(vtb + gv_off + ks * 32); } while (0)
#define GLA_LWRITE(bufp) do { LAS unsigned char* _bp = (bufp); \
    if (WITH_O) { { const int id = tid; LAS unsigned char* a = _bp + (id >> 4) * GQ_STR + (id & 15) * 16; \
      *(LAS u32x2*)a = (u32x2){qreg[0][0], qreg[0][1]}; *(LAS u32x2*)(a + 8) = (u32x2){qreg[0][2], qreg[0][3]}; } \
    { const int id = tid + 512; LAS unsigned char* a = _bp + (id >> 4) * GQ_STR + (id & 15) * 16; \
      *(LAS u32x2*)a = (u32x2){qreg[1][0], qreg[1][1]}; *(LAS u32x2*)(a + 8) = (u32x2){qreg[1][2], qreg[1][3]}; } } \
    { const int id = tid; *(LAS u32x4*)(_bp + GQ_BYTES + (id >> 3) * GK_STR + (id & 7) * 16) = kreg[0]; } \
    { const int id = tid + 512; *(LAS u32x4*)(_bp + GQ_BYTES + (id >> 3) * GK_STR + (id & 7) * 16) = kreg[1]; } \
    if (tid < 32) *(LAS f32x4*)(_bp + GQ_BYTES + GK_BYTES + tid * 16) = dreg; } while (0)
        GLA_GLOAD(c0); GLA_LWRITE(lds);
#pragma unroll
        for (int ks = 0; ks < 4; ++ks) vcur[ks] = vnext[ks];
        __syncthreads();
        for (int ci = 0; ci < SEGC; ++ci) {
            const int c = c0 + ci;
            LAS unsigned char* buf = lds + (ci & 1) * GBUF;
            if (ci + 1 < SEGC) GLA_GLOAD(c + 1);
            if (WITH_O) {
#pragma unroll
                for (int qt = 0; qt < 2; ++qt) {
                    f32x16 acc = zero16();
                    LAS unsigned char* qb = buf + (32 * qt + l32) * GQ_STR + g * 8;
#pragma unroll
                    for (int s = 0; s < 8; ++s) {
                        const u32x2 lo = *(const LAS u32x2*)(qb + s * 32), hi = *(const LAS u32x2*)(qb + s * 32 + 16);
                        u32x4 a4 = {lo[0], lo[1], hi[0], hi[1]};
                        acc = MFMA32(__builtin_bit_cast(bf16x8, a4), Sb[s], acc);
                    }
                    bf16_t* yp = Y + ((long)b * S_ + c * 64 + 32 * qt + 4 * g) * 1024 + dvc;
#pragma unroll
                    for (int i = 0; i < 16; ++i) yp[(long)(8 * (i >> 2) + (i & 3)) * 1024] = f2bf(acc[i]);
                }
            }
#pragma unroll
            for (int t = 0; t < 4; ++t) {
                LAS unsigned char* kb = buf + GQ_BYTES + (32 * t + l32) * GK_STR + g * 16;
#pragma unroll
                for (int ks = 0; ks < 4; ++ks) {
                    const bf16x8 a = *(const LAS bf16x8*)(kb + ks * 32);
                    St[t] = MFMA32(a, vcur[ks], St[t]);
                }
                LAS unsigned char* db = buf + GQ_BYTES + GK_BYTES + (32 * t + 4 * g) * 4;
#pragma unroll
                for (int a = 0; a < 4; ++a) {
                    const f32x4 d4 = *(const LAS f32x4*)(db + a * 32);
#pragma unroll
                    for (int jj = 0; jj < 4; ++jj) St[t][4 * a + jj] *= d4[jj];
                }
                if (WITH_O) { Sb[2 * t] = pack_lo(St[t]); Sb[2 * t + 1] = pack_hi(St[t]); }
            }
            if (ci + 1 < SEGC) { GLA_LWRITE(lds + ((ci + 1) & 1) * GBUF);
#pragma unroll
                for (int ks = 0; ks < 4; ++ks) vcur[ks] = vnext[ks]; }
            __syncthreads();
        }
        if (!WITH_O) {
#pragma unroll
            for (int t = 0; t < 4; ++t)
#pragma unroll
                for (int i = 0; i < 16; ++i) xw[(t * 16 + i) * 64] = St[t][i];
        }
    }
#undef GLA_GLOAD
#undef GLA_LWRITE
}
DI void phase_gla_combine(const Params& p, int wv) {
    float* X = (float*)(wsptr(p) + OFF_X); const float* DS = (const float*)(wsptr(p) + OFF_DS);
    const int tid_ = phase_tid(wv); const int tid = tid_;
    for (int idx = blockIdx.x * NTHR + tid; idx < 8 * 32768; idx += gridDim.x * NTHR) {
        const int bh = idx >> 15, e = idx & 32767;
        const int lane = e & 63, ti = (e >> 6) & 63, t = ti >> 4, i = ti & 15;
        const int dk = 32 * t + 8 * (i >> 2) + 4 * (lane >> 5) + (i & 3);
        float r = 0.f;
        float* xp = X + (long)bh * NSEG * 32768 + e;
        const float* dp = DS + bh * NSEG * 128 + dk;
#pragma unroll 4
        for (int seg = 0; seg < NSEG; ++seg) {
            const float tmp = xp[(long)seg * 32768], D = dp[seg * 128];
            xp[(long)seg * 32768] = r;
            r = r * D + tmp;
        }
    }
}

constexpr int OQ_STR = 272, OV_STR = 144, OQ_BYTES = 64 * OQ_STR, OV_BYTES = 256 * OV_STR, O_XS_OFF = 2 * OQ_BYTES + OV_BYTES;
DI void phase_gla_out(const Params& p, int wv, int j) {
    LAS unsigned char* lds = (LAS unsigned char*)smem;
    LAS float* OL = (LAS float*)(lds + O_XS_OFF);
    const bf16_t* Pb = (const bf16_t*)(wsptr(p) + OFF_P);
    const bf16_t* Q = Pb + GP_Q / 2; const bf16_t* K = Pb + GP_K / 2; const bf16_t* VT = Pb + GP_VT / 2; const bf16_t* R = Pb + GP_R / 2;
    bf16_t* Y = (bf16_t*)(wsptr(p) + OFF_Y);
    const float* ng = inptr(p, 4) + (long)j * 1024;
    const int tid_ = phase_tid(wv); const int tid = tid_, wid = __builtin_amdgcn_readfirstlane(tid >> 6), lane = tid & 63, l32 = lane & 31, g = lane >> 5;
    const int qt = wid & 1, dq = wid >> 1;
    const int qi = 32 * qt + l32;
    const int krow = (l32 & 19) | ((l32 & 4) << 1) | ((l32 & 8) >> 1);
    u32x4 qreg[2], kreg[2], vreg[4];
    const unsigned qk_off = (unsigned)((tid >> 4) * 512 + (tid & 15) * 8) * 2u, v_off = (unsigned)((tid >> 3) * S_ + (tid & 7) * 8) * 2u;
#define GO_GLOAD(uu) do { const int h_ = (uu) & 3, bc_ = (uu) >> 2, b_ = bc_ >> 8, c_ = bc_ & 255; const long t0_ = (long)b_ * S_ + c_ * 64; \
    const char* qb_ = (const char*)(Q + t0_ * 512 + h_ * 128); const char* kb_ = (const char*)(K + t0_ * 512 + h_ * 128); \
    const char* vb_ = (const char*)(VT + ((long)(b_ * 1024 + h_ * 256)) * S_ + c_ * 64); \
    qreg[0] = *(const u32x4*)(qb_ + qk_off); qreg[1] = *(const u32x4*)(qb_ + 32768 + qk_off); \
    kreg[0] = *(const u32x4*)(kb_ + qk_off); kreg[1] = *(const u32x4*)(kb_ + 32768 + qk_off); \
    _Pragma("unroll") for (int i_ = 0; i_ < 4; ++i_) vreg[i_] = *(const u32x4*)(vb_ + (size_t)i_ * 64 * S_ * 2 + v_off); } while (0)
#define GO_LWRITE() do { \
    *(LAS u32x4*)(lds + (tid >> 4) * OQ_STR + (tid & 15) * 16) = qreg[0]; *(LAS u32x4*)(lds + (32 + (tid >> 4)) * OQ_STR + (tid & 15) * 16) = qreg[1]; \
    *(LAS u32x4*)(lds + OQ_BYTES + (tid >> 4) * OQ_STR + (tid & 15) * 16) = kreg[0]; *(LAS u32x4*)(lds + OQ_BYTES + (32 + (tid >> 4)) * OQ_STR + (tid & 15) * 16) = kreg[1]; \
    _Pragma("unroll") for (int i_ = 0; i_ < 4; ++i_) *(LAS u32x4*)(lds + 2 * OQ_BYTES + (i_ * 64 + (tid >> 3)) * OV_STR + (tid & 7) * 16) = vreg[i_]; } while (0)
    if ((int)blockIdx.x < 2048) { GO_GLOAD(blockIdx.x); GO_LWRITE(); }
    __syncthreads();
    for (int u = blockIdx.x; u < 2048; u += gridDim.x) {
        const int h = u & 3, bc = u >> 2, b = bc >> 8, c = bc & 255;
        const long tok0 = (long)b * S_ + c * 64;
        const bool has_next = u + (int)gridDim.x < 2048;
        if (has_next) GO_GLOAD(u + gridDim.x);
        bf16x8 qf[8];
        { LAS unsigned char* qp = lds + qi * OQ_STR + g * 16;
#pragma unroll
          for (int s = 0; s < 8; ++s) qf[s] = *(const LAS bf16x8*)(qp + 32 * s); }
        f32x16 sT[2] = {zero16(), zero16()};
#pragma unroll
        for (int hh = 0; hh < 2; ++hh) {
            if (hh <= qt) {
                LAS unsigned char* kp = lds + OQ_BYTES + (32 * hh + krow) * OQ_STR + g * 16;
#pragma unroll
                for (int s = 0; s < 8; ++s) { const bf16x8 a = *(const LAS bf16x8*)(kp + 32 * s); sT[hh] = MFMA32(a, qf[s], sT[hh]); }
#pragma unroll
                for (int i = 0; i < 16; ++i) { const int key = 32 * hh + 16 * (i >> 3) + 8 * g + (i & 7); if (key > qi) sT[hh][i] = 0.f; }
            }
        }
        bf16x8 pb[4] = {pack_lo(sT[0]), pack_hi(sT[0]), pack_lo(sT[1]), pack_hi(sT[1])};
        f32x16 o[2] = {zero16(), zero16()};
#pragma unroll
        for (int dvt = 0; dvt < 2; ++dvt) {
            LAS unsigned char* vp = lds + 2 * OQ_BYTES + (dq * 64 + dvt * 32 + l32) * OV_STR + g * 16;
#pragma unroll
            for (int ss = 0; ss < 4; ++ss) {
                const bf16x8 a8 = *(const LAS bf16x8*)(vp + 32 * ss);
                o[dvt] = MFMA32(a8, pb[ss], o[dvt]);
            }
        }
        { LAS float* op = OL + qi * 260 + dq * 64 + 4 * g;
#pragma unroll
          for (int dvt = 0; dvt < 2; ++dvt)
#pragma unroll
              for (int a = 0; a < 4; ++a) *(LAS f32x4*)(op + dvt * 32 + a * 8) = (f32x4){o[dvt][4 * a], o[dvt][4 * a + 1], o[dvt][4 * a + 2], o[dvt][4 * a + 3]}; }
        __syncthreads();
        if (has_next) GO_LWRITE();
#pragma unroll
        for (int k = 0; k < 4; ++k) {
            const int cidx = tid + 512 * k, row = cidx >> 5, col = (cidx & 31) * 8;
            const f32x4 oa = *(const LAS f32x4*)(OL + row * 260 + col), ob = *(const LAS f32x4*)(OL + row * 260 + col + 4);
            bf16_t* yrow = Y + (tok0 + row) * 1024 + h * 256 + col;
            const u32x4 yi = *(const u32x4*)yrow;
            float v[8] = {oa[0] + bflo(yi[0]), oa[1] + bfhi(yi[0]), oa[2] + bflo(yi[1]), oa[3] + bfhi(yi[1]),
                          ob[0] + bflo(yi[2]), ob[1] + bfhi(yi[2]), ob[2] + bflo(yi[3]), ob[3] + bfhi(yi[3])};
            float sum = 0.f, ssq = 0.f;
#pragma unroll
            for (int e = 0; e < 8; ++e) { sum += v[e]; ssq += v[e] * v[e]; }
#pragma unroll
            for (int sh = 1; sh < 32; sh <<= 1) { sum += shx(sum, sh, lane); ssq += shx(ssq, sh, lane); }
            const float mu = sum * (1.f / 256.f), var = fmaxf(ssq * (1.f / 256.f) - mu * mu, 0.f), rstd = 1.0f / sqrtf(var + 1e-5f);
            const u32x4 ri = *(const u32x4*)(R + (tok0 + row) * 1024 + h * 256 + col);
            const f32x4 ga = *(const f32x4*)(ng + h * 256 + col), gb = *(const f32x4*)(ng + h * 256 + col + 4);
            const float rv[8] = {bflo(ri[0]), bfhi(ri[0]), bflo(ri[1]), bfhi(ri[1]), bflo(ri[2]), bfhi(ri[2]), bflo(ri[3]), bfhi(ri[3])};
            float yv[8];
#pragma unroll
            for (int e = 0; e < 8; ++e) { const float r = rv[e], gg = e < 4 ? ga[e & 3] : gb[e & 3]; yv[e] = r * __builtin_amdgcn_rcpf(1.f + __expf(-r)) * ((v[e] - mu) * rstd * gg); }
            *(u32x4*)yrow = (u32x4){pk2(yv[0], yv[1]), pk2(yv[2], yv[3]), pk2(yv[4], yv[5]), pk2(yv[6], yv[7])};
        }
        __syncthreads();
    }
#undef GO_GLOAD
#undef GO_LWRITE
}

#define XB_TMO      128
#define XB_XCNT(j)  (256  + 64 * (j))
#define XB_XSUB(j)  (1280 + 64 * (j))
#define XB_XGEN(j)  (2304 + 64 * (j))
#define XB_TOP      3328
#define XB_TOPGEN   3392
#define XCD_BAR_WORDS 3456
#define XB_SPIN_CAP (1u << 22)
DI unsigned xb_ld(unsigned* p) { return __hip_atomic_load(p, __ATOMIC_RELAXED, __HIP_MEMORY_SCOPE_AGENT); }
DI unsigned xb_add(unsigned* p, unsigned v) { return __hip_atomic_fetch_add(p, v, __ATOMIC_RELAXED, __HIP_MEMORY_SCOPE_AGENT); }
DI unsigned xb_xcc_id() { return (unsigned)__builtin_amdgcn_s_getreg((3 << 11) | 20) & 0xFu; }
#define XB_SPIN(cond, bar) do { unsigned _sp = 0; while (cond) { __builtin_amdgcn_s_sleep(1); \
    if ((++_sp & 255u) == 0u) { if (xb_ld(&(bar)[XB_TMO])) break; if (_sp > XB_SPIN_CAP) { atomicAdd(&(bar)[XB_TMO], 1u); break; } } } } while (0)
DI void xcd_barrier_complete(unsigned* bar, unsigned x, unsigned& nloc, unsigned& nx) {
    const unsigned G = gridDim.x;
    unsigned sum, cnt, mine, sp = 0u;
    for (;;) {
        sum = 0u; cnt = 0u; mine = 0u;
#pragma unroll
        for (unsigned j = 0; j < 16; ++j) { const unsigned c = xb_ld(&bar[XB_XCNT(j)]); sum += c; cnt += (c > 0u) ? 1u : 0u; mine = (j == x) ? c : mine; }
        if (sum == G) break;
        __builtin_amdgcn_s_sleep(1);
        if ((++sp & 255u) == 0u) { if (xb_ld(&bar[XB_TMO])) break; if (sp > XB_SPIN_CAP) { atomicAdd(&bar[XB_TMO], 1u); break; } }
    }
    nloc = mine > 0u ? mine : 1u; nx = cnt > 0u ? cnt : 1u;
}
DI void grid_bar(unsigned* bar) {
    volatile LAS unsigned* st = (volatile LAS unsigned*)((LAS unsigned char*)smem + LDS_BYTES);
    asm volatile("s_waitcnt vmcnt(0)" ::: "memory");
    __syncthreads();
    if (threadIdx.x == 0) {
        __builtin_amdgcn_s_waitcnt(0);
        const unsigned x = xb_xcc_id();
        unsigned nloc = st[0], nx = st[1];
        if (nloc == 0u) { xcd_barrier_complete(bar, x, nloc, nx); st[0] = nloc; st[1] = nx; }
        const unsigned old = xb_add(&bar[XB_XSUB(x)], 1u);
        const unsigned gen = old / nloc;
        if (old + 1u == (gen + 1u) * nloc) {
            __builtin_amdgcn_fence(__ATOMIC_RELEASE, "agent");
            asm volatile("s_waitcnt vmcnt(0)" ::: "memory");
            const unsigned og = xb_add(&bar[XB_TOP], 1u);
            const unsigned tg = og / nx;
            if (og + 1u == (tg + 1u) * nx) xb_add(&bar[XB_TOPGEN], 1u);
            else XB_SPIN(xb_ld(&bar[XB_TOPGEN]) == tg, bar);
            __builtin_amdgcn_fence(__ATOMIC_ACQUIRE, "agent");
            xb_add(&bar[XB_XGEN(x)], 1u);
            asm volatile("s_waitcnt vmcnt(0)" ::: "memory");
        } else {
            XB_SPIN(xb_ld(&bar[XB_XGEN(x)]) == gen, bar);
            __builtin_amdgcn_fence(__ATOMIC_ACQUIRE, "agent");
            asm volatile("s_waitcnt vmcnt(0)" ::: "memory");
        }
    }
    __syncthreads();
}
#ifndef PHM
#define PHM 0xFFFF
#endif
#define PH(k) ((PHM >> (k)) & 1)
__global__ void __launch_bounds__(NTHR) fwd_kernel(Params p) {
    cg::grid_group grid = cg::this_grid();
    const int wv = __builtin_amdgcn_readfirstlane((int)threadIdx.x >> 6);
    unsigned* bar = (unsigned*)wsptr(p);
    { volatile LAS unsigned* st = (volatile LAS unsigned*)((LAS unsigned char*)smem + LDS_BYTES);
      if (threadIdx.x == 0) { st[0] = 0u; st[1] = 0u; (void)xb_add(&bar[XB_XCNT(xb_xcc_id())], 1u); } __syncthreads(); }
#define W ((const bf16_t*)(wsptr(p) + OFF_W))
#define HB ((bf16_t*)(wsptr(p) + OFF_HB))
#define Y ((bf16_t*)(wsptr(p) + OFF_Y))
#define Pb ((bf16_t*)(wsptr(p) + OFF_P))
#define H (outptr(p))
#define STATP ((float*)(wsptr(p) + OFF_STAT))
#define LNG(i) (inptr(p, 17) + (long)(i) * 1024)
#define LNB(i) (inptr(p, 18) + (long)(i) * 1024)
#define LNXP(i) ((unsigned long long*)(wsptr(p) + OFF_LNX) + (long)(i) * 131072)
#define LNCP(i) ((unsigned*)(wsptr(p) + OFF_LNC) + (i) * 2048)

    if (PH(0)) phase_convert(p, wv);
    if (p.conv_tiles < 0) grid.sync();
    grid_bar((unsigned*)wsptr(p));
#pragma unroll 1
    for (int layer = 0; layer < 4; ++layer) {
        const int mix = layer % 3, j = layer / 3;
        if (mix == 0) {
            if (PH(1)) { EpiGlaIn e{Pb, (float*)(wsptr(p) + OFF_P + GP_GL)}; gemm_phase(wv, HB, 1024, W + p.w_gla_in[j], 1024, T_, 3328, 1024, e); }
            grid_bar((unsigned*)wsptr(p));
            if (PH(2)) phase_gla_prep(p, wv, j);
            grid_bar((unsigned*)wsptr(p));
            if (PH(3)) phase_gla_scan<false>(p, wv);
            grid_bar((unsigned*)wsptr(p));
            if (PH(3)) phase_gla_combine(p, wv);
            grid_bar((unsigned*)wsptr(p));
            if (PH(3)) phase_gla_scan<true>(p, wv);
            grid_bar((unsigned*)wsptr(p));
            if (PH(4)) phase_gla_out(p, wv, j);
            grid_bar((unsigned*)wsptr(p));
            if (PH(5)) { EpiResLN e{(layer == 0) ? inptr(p, 0) : H, H, HB, LNG(layer * 2), LNB(layer * 2), LNXP(layer * 2), LNCP(layer * 2)}; gemm_phase(wv, Y, 1024, W + p.w_gla_out[j], 1024, T_, 1024, 1024, e); }
        } else if (mix == 1) {
            if (PH(6)) { EpiRpaIn e{Pb, 0.125f * LOG2E}; gemm_phase(wv, HB, 1024, W + p.w_rpa_in, 1024, T_, 3072, 1024, e); }
            grid_bar((unsigned*)wsptr(p));
            if (PH(7)) phase_rpa_attn(p, wv);
            grid_bar((unsigned*)wsptr(p));
            if (PH(5)) { EpiResLN e{(layer == 0) ? inptr(p, 0) : H, H, HB, LNG(layer * 2), LNB(layer * 2), LNXP(layer * 2), LNCP(layer * 2)}; gemm_phase(wv, Y, 1024, W + p.w_rpa_out, 1024, T_, 1024, 1024, e); }
        } else {
            if (PH(8)) { EpiPlain e{Y, 768, 1.f}; gemm_phase(wv, HB, 1024, W + p.w_mla_in, 1024, T_, 768, 1024, e); }
            grid_bar((unsigned*)wsptr(p));
            if (PH(9)) phase_mla_norm(p, wv);
            grid_bar((unsigned*)wsptr(p));
            if (PH(8)) { EpiPlain e{Pb + MP_Q / 2, 1536, 0.07216878364870322f * LOG2E}; gemm_phase(wv, Y, 768, W + p.w_mla_uq, 384, T_, 1536, 384, e); }
            if (PH(10)) { EpiMlaKv e{Pb + MP_KN / 2, Pb + MP_VT / 2}; gemm_phase(wv, Y + 384, 768, W + p.w_mla_ukv, 256, T_, 2048, 256, e); }
            grid_bar((unsigned*)wsptr(p));
            if (PH(11)) phase_mla_attn(p, wv);
            grid_bar((unsigned*)wsptr(p));
            if (PH(5)) { EpiResLN e{(layer == 0) ? inptr(p, 0) : H, H, HB, LNG(layer * 2), LNB(layer * 2), LNXP(layer * 2), LNCP(layer * 2)}; gemm_phase(wv, Y, 1024, W + p.w_mla_out, 1024, T_, 1024, 1024, e); }
        }
        grid_bar((unsigned*)wsptr(p));
        if (PH(13)) { EpiSwiglu e{Pb}; gemm_phase(wv, HB, 1024, W + p.w_ffn_in[layer], 1024, T_, 2 * FFH, 1024, e); }
        grid_bar((unsigned*)wsptr(p));
        if (PH(5)) { EpiResLN e{H, H, HB, LNG(layer * 2 + 1), LNB(layer * 2 + 1), LNXP(layer * 2 + 1), LNCP(layer * 2 + 1)}; gemm_phase(wv, Pb, FFH, W + p.w_ffn_out[layer], FFH, T_, 1024, FFH, e); }
        grid_bar((unsigned*)wsptr(p));
    }
}

#undef W
#undef HB
#undef Y
#undef Pb
#undef H
#undef STATP
#undef LNG
#undef LNB
#undef LNXP
#undef LNCP
extern "C" void kernel_launch(void* const* d_in, const int* in_sizes, int n_in, void* d_out, int out_size, void* d_ws, size_t ws_size, hipStream_t stream) {
    static int grid_blocks = 0;
    if (!grid_blocks) {
        int dev = 0, cus = 0, per_cu = 0;
        hipGetDevice(&dev);
        hipDeviceGetAttribute(&cus, hipDeviceAttributeMultiprocessorCount, dev);
        hipFuncSetAttribute((const void*)fwd_kernel, hipFuncAttributeMaxDynamicSharedMemorySize, LDS_BYTES + 64);
        hipOccupancyMaxActiveBlocksPerMultiprocessor(&per_cu, (const void*)fwd_kernel, NTHR, LDS_BYTES + 64);
        if (per_cu < 1) per_cu = 1;
        grid_blocks = cus * per_cu;
        if (ws_size < 472 * MiB) fprintf(stderr, "kernel_launch: workspace too small: %zu\n", ws_size);
    }
    Params p; memset(&p, 0, sizeof(p));
    for (int i = 0; i < 19; ++i) p.in[i] = (const float*)d_in[i];
    p.out = (float*)d_out; p.ws = (unsigned char*)d_ws;
    long woff = 0; int nd = 0, tiles = 0;
    auto add = [&](int idx, long src_off, int K, int Nsrc, int Npad, int perm) -> long {
        ConvDesc& c = p.cd[nd++]; c.in_idx = idx; c.K = K; c.Nsrc = Nsrc; c.Npad = Npad; c.perm = perm; c.tile0 = tiles; c.src_off = src_off; c.dst_off = woff;
        tiles += (K / 64) * (Npad / 64); const long o = woff; woff += (long)K * Npad; return o;
    };
    for (int j = 0; j < 2; ++j) { p.w_gla_in[j] = add(1, (long)j * 1024 * 3088, 1024, 3088, 3328, 0); p.w_gla_out[j] = add(5, (long)j * 1024 * 1024, 1024, 1024, 1024, 0); }
    p.w_rpa_in = add(6, 0, 1024, 3072, 3072, 0); p.w_rpa_out = add(8, 0, 1024, 1024, 1024, 0);
    p.w_mla_in = add(9, 0, 1024, 704, 768, 0); p.w_mla_uq = add(12, 0, 384, 1536, 1536, 0); p.w_mla_ukv = add(13, 0, 256, 2048, 2048, 0); p.w_mla_out = add(14, 0, 1024, 1024, 1024, 0);
    for (int l = 0; l < 4; ++l) { p.w_ffn_in[l] = add(15, (long)l * 1024 * 5632, 1024, 5632, 5632, 1); p.w_ffn_out[l] = add(16, (long)l * FFH * 1024, FFH, 1024, 1024, 0); }
    p.ncd = nd; p.conv_tiles = tiles;
    hipMemsetAsync(d_ws, 0, 131072, stream);
    void* args[] = {&p};
    hipError_t e = hipLaunchCooperativeKernel((const void*)fwd_kernel, dim3(grid_blocks), dim3(NTHR), args, LDS_BYTES + 64, stream);
    if (e != hipSuccess) fprintf(stderr, "cooperative launch failed: %s (grid %d)\n", hipGetErrorString(e), grid_blocks);
}
```
